# Optimizing an MI355X kernel written in HIP

```python
import jax, jax.numpy as jnp
from jax import lax
import numpy as np

D_MODEL = 1024
BATCH = 16
SEQ = 256
DEPTH = 4
DEC_BATCH = 8
DEC_SEQ = 2048
PAST_LEN = 256

GRID_W = 64
HEAD_DIM = 64
N_GROUPS = 4
GROUP_W = D_MODEL // N_GROUPS
A_HEADS = GROUP_W // HEAD_DIM
A_KV = max(1, A_HEADS // 2)
B_HEADS = GROUP_W // HEAD_DIM
C_HEADS = GROUP_W // HEAD_DIM
D_HEADS = GROUP_W // HEAD_DIM
WINDOW = 128
QBLK = 128
NA_ROWS = 8
NA_COLS = 16
NA_QCOLS = 16
NA_KCOLS = 32
NCB = GRID_W // NA_QCOLS
CHUNK = 64
ROPE_BASE = 10000.0
EPS = 1e-6
NEG = -1e30
LB_FLOOR = 1e-30
IN_WIDTHS = (GROUP_W, A_KV * HEAD_DIM, A_KV * HEAD_DIM, GROUP_W,
             GROUP_W, GROUP_W, GROUP_W, GROUP_W,
             GROUP_W, GROUP_W, GROUP_W, GROUP_W,
             GROUP_W, GROUP_W, GROUP_W, GROUP_W, GROUP_W)
IN_WIDTH = sum(IN_WIDTHS)

kernel_name = 'hybrid_diffusion_parallel_heads_step'


def rmsnorm(x, g):
    x32 = x.astype(jnp.float32)
    y = x32 * lax.rsqrt(jnp.mean(x32 * x32, axis=-1, keepdims=True) + EPS)
    return (y * g.astype(jnp.float32)).astype(x.dtype)


def adaln(cvec, w, b):
    m = jax.nn.silu(cvec) @ w + b
    return jnp.split(m, 3, axis=-1)


def rope_2d(x):
    bsz, slen, nh, hd = x.shape
    t = jnp.arange(slen)
    half = hd // 2
    nf = half // 2
    freqs = ROPE_BASE ** (-jnp.arange(nf, dtype=jnp.float32) / nf)

    def rot(xa, pos):
        ang = pos.astype(jnp.float32)[:, None] * freqs[None, :]
        cos = jnp.cos(ang)[None, :, None, :]
        sin = jnp.sin(ang)[None, :, None, :]
        x1, x2 = xa[..., :nf], xa[..., nf:]
        return jnp.concatenate([x1 * cos - x2 * sin, x2 * cos + x1 * sin], axis=-1)

    x32 = x.astype(jnp.float32)
    out = jnp.concatenate([rot(x32[..., :half], t // GRID_W), rot(x32[..., half:], t % GRID_W)], axis=-1)
    return out.astype(x.dtype)


def split_branches(h, w_in):
    bsz, slen = h.shape[:2]
    parts = jnp.split(h @ w_in, np.cumsum(IN_WIDTHS)[:-1].tolist(), axis=-1)
    return [p.reshape(bsz, slen, -1, HEAD_DIM) for p in parts]


def finish(x, outs, gates, w_out, g_post, gate_mod):
    bsz, slen = x.shape[:2]
    mixed = jnp.concatenate(
        [(o.astype(x.dtype) * jax.nn.silu(g)).reshape(bsz, slen, GROUP_W) for o, g in zip(outs, gates)], axis=-1)
    return x + gate_mod * rmsnorm(mixed @ w_out, g_post)


def dense_attn(q, k, v, sink):
    bsz, slen, nh, hd = q.shape
    nkv = k.shape[2]
    grp = nh // nkv
    nb = slen // QBLK
    nk = k.shape[1]
    qb = jnp.moveaxis(q.reshape(bsz, nb, QBLK, nkv, grp, hd), 1, 0)

    def block(qi):
        s = jnp.einsum('bqkgd,bskd->bkgqs', qi, k, preferred_element_type=jnp.float32) * hd ** -0.5
        if sink is not None:
            sk = jnp.broadcast_to(sink.astype(jnp.float32).reshape(1, nkv, grp, 1, 1), s.shape[:-1] + (1,))
            s = jnp.concatenate([s, sk], axis=-1)
        p = jax.nn.softmax(s, axis=-1)[..., :nk].astype(v.dtype)
        return jnp.einsum('bkgqs,bskd->bqkgd', p, v)

    o = lax.map(block, qb)
    return jnp.moveaxis(o, 0, 1).reshape(bsz, slen, nh, hd)


def window_attn(q, k, v, k_ctx, v_ctx, sink):
    bsz, slen, nh, hd = q.shape
    nkv = k.shape[2]
    grp = nh // nkv
    nb = slen // QBLK
    qb = q.reshape(bsz, nb, QBLK, nkv, grp, hd)

    def band(t):
        tp = jnp.pad(t, ((0, 0), (QBLK, QBLK), (0, 0), (0, 0))).reshape(bsz, nb + 2, QBLK, nkv, hd)
        return jnp.concatenate([tp[:, :-2], tp[:, 1:-1], tp[:, 2:]], axis=2)

    kb, vb = band(k), band(v)
    blk = np.arange(nb)[:, None]
    qpos = blk * QBLK + np.arange(QBLK)[None, :]
    kpos = (blk - 1) * QBLK + np.arange(3 * QBLK)[None, :]
    mask = ((kpos[:, None, :] >= 0) & (kpos[:, None, :] < slen)
            & (np.abs(qpos[:, :, None] - kpos[:, None, :]) <= WINDOW))
    scale = hd ** -0.5
    s_loc = jnp.einsum('bnqkgd,bnskd->bnkgqs', qb, kb, preferred_element_type=jnp.float32) * scale
    s_loc = jnp.where(mask[None, :, None, None], s_loc, NEG)
    s_ctx = jnp.einsum('bnqkgd,bskd->bnkgqs', qb, k_ctx, preferred_element_type=jnp.float32) * scale
    sk = jnp.broadcast_to(sink.astype(jnp.float32).reshape(1, 1, nkv, grp, 1, 1), s_loc.shape[:-1] + (1,))
    p = jax.nn.softmax(jnp.concatenate([s_loc, s_ctx, sk], axis=-1), axis=-1).astype(v.dtype)
    nloc = 3 * QBLK
    nctx = k_ctx.shape[1]
    o = (jnp.einsum('bnkgqs,bnskd->bnqkgd', p[..., :nloc], vb)
         + jnp.einsum('bnkgqs,bskd->bnqkgd', p[..., nloc:nloc + nctx], v_ctx))
    return o.reshape(bsz, slen, nh, hd)


def neighborhood_attn(q, k, v, k_ctx, v_ctx, rpb):
    bsz, slen, nh, hd = q.shape
    rows = slen // GRID_W
    wr = min(NA_ROWS, rows)
    r = np.arange(rows)
    row_idx = np.clip(r - wr // 2, 0, rows - wr)[:, None] + np.arange(wr)[None, :]
    kcol0 = np.clip(np.arange(NCB) * NA_QCOLS - (NA_KCOLS - NA_QCOLS) // 2, 0, GRID_W - NA_KCOLS)
    col_idx = kcol0[:, None] + np.arange(NA_KCOLS)[None, :]
    qcol = np.arange(NCB)[:, None] * NA_QCOLS + np.arange(NA_QCOLS)[None, :]
    qws = np.clip(qcol - NA_COLS // 2, 0, GRID_W - NA_COLS)
    col_ok = ((col_idx[:, None, :] >= qws[:, :, None])
              & (col_idx[:, None, :] < qws[:, :, None] + NA_COLS))
    nkeys = wr * NA_KCOLS
    mask = np.broadcast_to(col_ok[:, :, None, :], (NCB, NA_QCOLS, wr, NA_KCOLS)).reshape(NCB, NA_QCOLS, nkeys)
    ri = (row_idx - r[:, None]) + NA_ROWS - 1
    ci = np.clip(col_idx[:, None, :] - qcol[:, :, None], -(NA_COLS - 1), NA_COLS - 1) + NA_COLS - 1
    bias = rpb.astype(jnp.float32)[:, ri[:, None, None, :, None], ci[None, :, :, None, :]]
    bias = jnp.transpose(bias.reshape(nh, rows, NCB, NA_QCOLS, nkeys), (1, 2, 0, 3, 4))

    def gather(t):
        t5 = t.reshape(bsz, rows, GRID_W, nh, hd)
        g = t5[:, row_idx[:, None, :, None], col_idx[None, :, None, :]]
        return g.reshape(bsz, rows, NCB, nkeys, nh, hd)

    kb, vb = gather(k), gather(v)
    qb = q.reshape(bsz, rows, NCB, NA_QCOLS, nh, hd)
    scale = hd ** -0.5
    s_loc = jnp.einsum('brcqhd,brckhd->brchqk', qb, kb, preferred_element_type=jnp.float32) * scale + bias[None]
    s_loc = jnp.where(mask[None, None, :, None], s_loc, NEG)
    s_ctx = jnp.einsum('brcqhd,bshd->brchqs', qb, k_ctx, preferred_element_type=jnp.float32) * scale
    p = jax.nn.softmax(jnp.concatenate([s_loc, s_ctx], axis=-1), axis=-1).astype(v.dtype)
    o = (jnp.einsum('brchqk,brckhd->brcqhd', p[..., :nkeys], vb)
         + jnp.einsum('brchqs,bshd->brcqhd', p[..., nkeys:], v_ctx))
    return o.reshape(bsz, slen, nh, hd)


def _chunks(t, nc):
    bsz, slen, nh, d = t.shape
    return jnp.moveaxis(t.astype(jnp.float32).reshape(bsz, nc, CHUNK, nh, d), 1, 0)


def retention_scan(q, k, v, log_gamma, s0):
    bsz, slen, nh, _ = q.shape
    nc = slen // CHUNK
    lg = log_gamma.astype(jnp.float32)
    idx = jnp.arange(CHUNK, dtype=jnp.float32)
    dist = idx[:, None] - idx[None, :]
    decay = jnp.where(dist >= 0, jnp.exp(jnp.maximum(dist, 0.0)[None] * lg[:, None, None]), 0.0)
    q_decay = jnp.exp((idx[:, None] + 1.0) * lg[None, :])
    k_decay = jnp.exp((CHUNK - 1.0 - idx)[:, None] * lg[None, :])
    chunk_decay = jnp.exp(CHUNK * lg)

    def step(state, inp):
        qc, kc, vc = inp
        scores = jnp.einsum('bqhd,bkhd->bhqk', qc, kc) * decay
        intra = jnp.einsum('bhqk,bkhe->bqhe', scores, vc)
        cross = jnp.einsum('bqhd,bhde->bqhe', qc, state) * q_decay[None, :, :, None]
        new = (state * chunk_decay[None, :, None, None]
               + jnp.einsum('bkhd,bkhe->bhde', kc * k_decay[None, :, :, None], vc))
        return new, intra + cross

    s_fin, o = lax.scan(step, s0.astype(jnp.float32), (_chunks(q, nc), _chunks(k, nc), _chunks(v, nc)))
    return jnp.moveaxis(o, 0, 1).reshape(bsz, slen, nh, v.shape[-1]), s_fin


def hgrn2_scan(q, log_f, k, v, s0):
    bsz, slen, nh, _ = q.shape
    nc = slen // CHUNK
    causal = jnp.tril(jnp.ones((CHUNK, CHUNK), dtype=bool))

    def step(state, inp):
        qc, lfc, kc, vc = inp
        b = jnp.cumsum(lfc, axis=1)
        diff = b[:, :, None] - b[:, None, :]
        w = jnp.where(causal[None, :, :, None, None], jnp.exp(jnp.minimum(diff, 0.0)), 0.0)
        attn = jnp.einsum('bihd,bjhd,bijhd->bhij', qc, kc, w)
        intra = jnp.einsum('bhij,bjhe->bihe', attn, vc)
        cross = jnp.einsum('bihd,bhde->bihe', qc * jnp.exp(b), state)
        b_last = b[:, -1]
        new = (state * jnp.exp(b_last)[..., None]
               + jnp.einsum('bjhd,bjhe->bhde', kc * jnp.exp(b_last[:, None] - b), vc))
        return new, intra + cross

    xs = (_chunks(q, nc), _chunks(log_f, nc), _chunks(k, nc), _chunks(v, nc))
    s_fin, o = lax.scan(step, s0.astype(jnp.float32), xs)
    return jnp.moveaxis(o, 0, 1).reshape(bsz, slen, nh, v.shape[-1]), s_fin


def retention_branch(q, k, v, log_gamma, s0_f, s0_b):
    k = k * HEAD_DIM ** -0.5
    o_f, s_f = retention_scan(q, k, v, log_gamma[0], s0_f)
    o_b, s_b = retention_scan(q[:, ::-1], k[:, ::-1], v[:, ::-1], log_gamma[1], s0_b)
    o = o_f + o_b[:, ::-1]
    mu = jnp.mean(o, axis=-1, keepdims=True)
    var = jnp.mean(jnp.square(o - mu), axis=-1, keepdims=True)
    o = (o - mu) * lax.rsqrt(var + EPS)
    return o, jnp.stack([s_f, s_b], axis=1)


def hgrn2_branch(q, z_f, z_b, v, lb, s0_f, s0_b):
    q = jax.nn.silu(q)

    def forget(z, lbd):
        lbd = jnp.maximum(lbd, LB_FLOOR)
        log_f = jnp.logaddexp(jnp.log(lbd), jnp.log1p(-lbd) + jax.nn.log_sigmoid(z.astype(jnp.float32)))
        return log_f, 1.0 - jnp.exp(log_f)

    lf_f, k_f = forget(z_f, lb[0])
    o_f, s_f = hgrn2_scan(q, lf_f, k_f, v, s0_f)
    lf_b, k_b = forget(z_b[:, ::-1], lb[1])
    o_b, s_b = hgrn2_scan(q[:, ::-1], lf_b, k_b, v[:, ::-1], s0_b)
    o = o_f + o_b[:, ::-1]
    o = o * lax.rsqrt(jnp.mean(o * o, axis=-1, keepdims=True) + EPS)
    return o, jnp.stack([s_f, s_b], axis=1)


def context_layer(x, c_ctx, w_ada_l, b_ada_l, g_pre_l, g_post_l, w_in_l, w_out_l, sink_l, log_gamma_l, lb_l):
    shift, scale, gate = adaln(c_ctx, w_ada_l, b_ada_l)
    h = rmsnorm(x, g_pre_l) * (1.0 + scale) + shift
    aq, ak, av, ag, bq, bk, bv, bg, cq, ck, cv, cg, dq, dzf, dzb, di, dg = split_branches(h, w_in_l)
    bsz = x.shape[0]
    zc = jnp.zeros((bsz, C_HEADS, HEAD_DIM, HEAD_DIM), jnp.float32)
    zd = jnp.zeros((bsz, D_HEADS, HEAD_DIM, HEAD_DIM), jnp.float32)
    o_a = dense_attn(aq, ak, av, sink_l)
    o_b = dense_attn(bq, bk, bv, None)
    o_c, s_c = retention_branch(cq, ck, cv, log_gamma_l, zc, zc)
    o_d, s_d = hgrn2_branch(dq, dzf, dzb, di, lb_l, zd, zd)
    x = finish(x, (o_a, o_b, o_c, o_d), (ag, bg, cg, dg), w_out_l, g_post_l, gate)
    return x, (ak, av, bk, bv, s_c, s_d)


def latent_layer(x, c, ca_k, ca_v, cb_k, cb_v, st_c, st_d, w_ada_l, b_ada_l, g_pre_l, g_post_l,
                 w_in_l, w_out_l, sink_l, rpb_l, log_gamma_l, lb_l):
    shift, scale, gate = [m[:, None, :] for m in adaln(c, w_ada_l, b_ada_l)]
    h = rmsnorm(x, g_pre_l) * (1.0 + scale) + shift
    aq, ak, av, ag, bq, bk, bv, bg, cq, ck, cv, cg, dq, dzf, dzb, di, dg = split_branches(h, w_in_l)
    o_a = window_attn(rope_2d(aq), rope_2d(ak), av, ca_k, ca_v, sink_l)
    o_b = neighborhood_attn(bq, bk, bv, cb_k, cb_v, rpb_l)
    o_c, _ = retention_branch(rope_2d(cq), rope_2d(ck), cv, log_gamma_l, st_c[:, 0], st_c[:, 1])
    o_d, _ = hgrn2_branch(dq, dzf, dzb, di, lb_l, st_d[:, 0], st_d[:, 1])
    return finish(x, (o_a, o_b, o_c, o_d), (ag, bg, cg, dg), w_out_l, g_post_l, gate)


def setup_inputs(seed: int = 0) -> dict:
    key = jax.random.key(seed)
    ks = jax.random.split(key, 20)
    nrm = jax.random.normal
    f32 = jnp.float32
    ret_init = jnp.log(2.0 ** (5.0 + jnp.arange(C_HEADS, dtype=f32)) - 1.0)
    return {
        'x_prompt': nrm(ks[0], (BATCH, SEQ, D_MODEL), f32),
        'x_sample': nrm(ks[1], (DEC_BATCH, DEC_SEQ, D_MODEL), f32),
        'c': nrm(ks[2], (DEC_BATCH, D_MODEL), f32),
        'cache_win_k': nrm(ks[3], (DEC_BATCH, DEPTH, PAST_LEN, A_KV, HEAD_DIM), f32),
        'cache_win_v': nrm(ks[4], (DEC_BATCH, DEPTH, PAST_LEN, A_KV, HEAD_DIM), f32),
        'cache_na_k': nrm(ks[5], (DEC_BATCH, DEPTH, PAST_LEN, B_HEADS, HEAD_DIM), f32),
        'cache_na_v': nrm(ks[6], (DEC_BATCH, DEPTH, PAST_LEN, B_HEADS, HEAD_DIM), f32),
        'state_ret': nrm(ks[7], (DEC_BATCH, DEPTH, 2, C_HEADS, HEAD_DIM, HEAD_DIM), f32),
        'state_hgrn': nrm(ks[8], (DEC_BATCH, DEPTH, 2, D_HEADS, HEAD_DIM, HEAD_DIM), f32),
        'c_ctx': nrm(ks[9], (D_MODEL,), f32),
        'w_ada': nrm(ks[10], (DEPTH, D_MODEL, 3 * D_MODEL), f32) * D_MODEL ** -0.5,
        'b_ada': nrm(ks[11], (DEPTH, 3 * D_MODEL), f32) * 0.02,
        'g_pre': 1.0 + 0.02 * nrm(ks[12], (DEPTH, D_MODEL), f32),
        'g_post': 1.0 + 0.02 * nrm(ks[13], (DEPTH, D_MODEL), f32),
        'w_in': nrm(ks[14], (DEPTH, D_MODEL, IN_WIDTH), f32) * D_MODEL ** -0.5,
        'w_out': nrm(ks[15], (DEPTH, D_MODEL, D_MODEL), f32) * D_MODEL ** -0.5,
        'attn_sink': nrm(ks[16], (DEPTH, A_HEADS), f32) * 0.5,
        'na_rpb': nrm(ks[17], (DEPTH, B_HEADS, 2 * NA_ROWS - 1, 2 * NA_COLS - 1), f32) * 0.1,
        'ret_decay_logit': ret_init[None, None, :] + 0.1 * nrm(ks[18], (DEPTH, 2, C_HEADS), f32),
        'hgrn_lb_logit': nrm(ks[19], (DEPTH, 2, D_HEADS * HEAD_DIM), f32) * 0.5,
    }


def reference(x_prompt, x_sample, c, cache_win_k, cache_win_v, cache_na_k, cache_na_v, state_ret, state_hgrn,
              c_ctx, w_ada, b_ada, g_pre, g_post, w_in, w_out, attn_sink, na_rpb, ret_decay_logit, hgrn_lb_logit):
    p_lb = jax.nn.softmax(hgrn_lb_logit.astype(jnp.float32), axis=0)
    lower_bounds = (jnp.cumsum(p_lb, axis=0) - p_lb[0:1]).reshape(DEPTH, 2, D_HEADS, HEAD_DIM)
    log_gammas = jax.nn.log_sigmoid(ret_decay_logit.astype(jnp.float32))

    x = x_prompt
    win_k, win_v, na_k, na_v, st_ret, st_hgrn = [], [], [], [], [], []
    for l in range(DEPTH):
        x, (ak, av, bk, bv, s_c, s_d) = context_layer(
            x, c_ctx, w_ada[l], b_ada[l], g_pre[l], g_post[l], w_in[l], w_out[l],
            attn_sink[l], log_gammas[l], lower_bounds[l])
        win_k.append(ak)
        win_v.append(av)
        na_k.append(bk)
        na_v.append(bv)
        st_ret.append(s_c)
        st_hgrn.append(s_d)
    y_prompt = x
    new_win_k = jnp.stack(win_k, axis=1)
    new_win_v = jnp.stack(win_v, axis=1)
    new_na_k = jnp.stack(na_k, axis=1)
    new_na_v = jnp.stack(na_v, axis=1)
    new_state_ret = jnp.stack(st_ret, axis=1)
    new_state_hgrn = jnp.stack(st_hgrn, axis=1)

    x = x_sample
    for l in range(DEPTH):
        x = latent_layer(
            x, c, cache_win_k[:, l], cache_win_v[:, l], cache_na_k[:, l], cache_na_v[:, l],
            state_ret[:, l], state_hgrn[:, l], w_ada[l], b_ada[l], g_pre[l], g_post[l], w_in[l], w_out[l],
            attn_sink[l], na_rpb[l], log_gammas[l], lower_bounds[l])
    y_sample = x
    return (y_prompt, y_sample, new_win_k, new_win_v, new_na_k, new_na_v, new_state_ret, new_state_hgrn)
```

```cpp
#include <hip/hip_runtime.h>
#include <hip/hip_cooperative_groups.h>
#include <cstdio>
#include <cstdint>
namespace cg = cooperative_groups;

typedef unsigned short u16;
typedef __attribute__((ext_vector_type(8))) short bf16x8;
typedef __attribute__((ext_vector_type(4))) float f32x4;

#define LOG2E 1.4426950408889634f
#define NTOK 20480
#define NCTX 4096
#define LDS_BYTES 75776
#define HS 1024
#define WS 1024
#ifndef REP_P1
#define REP_P1 1
#endif
#ifndef REP_SCAN
#define REP_SCAN 1
#endif
#ifndef REP_P2
#define REP_P2 1
#endif
#ifndef REP_P3A
#define REP_P3A 1
#endif
#ifndef REP_P3B
#define REP_P3B 1
#endif
#ifndef REP_P3C
#define REP_P3C 1
#endif
#ifndef REP_P4
#define REP_P4 1
#endif
#ifndef EXTRA_SYNC
#define EXTRA_SYNC 0
#endif

struct Params {
  const float *x_prompt, *x_sample, *c, *cwk, *cwv, *cnk, *cnv, *st_ret, *st_hgrn, *c_ctx,
      *w_ada, *b_ada, *g_pre, *g_post, *w_in, *w_out, *sink, *rpb, *ret_logit, *lb_logit;
  float* out;
  u16 *wt_in, *wt_out, *hbuf, *proj, *uc, *ud;
  float *dg, *mod, *rope;
  u16* ybuf;
  unsigned* bar;
  u16 *cbak, *cbav, *cbbk, *cbbv;
};

#define OUT_WK 20971520
#define OUT_WV 23068672
#define OUT_NK 25165824
#define OUT_NV 29360128
#define OUT_SR 33554432
#define OUT_SH 35651584

__device__ __forceinline__ int otid() { int t = threadIdx.x; asm volatile("" : "+v"(t)); return t; }
typedef __bf16 bf2_t __attribute__((ext_vector_type(2)));
__device__ __forceinline__ unsigned pack2(float a, float b) { bf2_t v; v[0] = (__bf16)a; v[1] = (__bf16)b; return __builtin_bit_cast(unsigned, v); }
__device__ __forceinline__ u16 f2bf(float f) { return (u16)(pack2(f, 0.f) & 0xffffu); }
__device__ __forceinline__ float bf2f(u16 h) { return __uint_as_float(((unsigned)h) << 16); }
__device__ __forceinline__ float bflo(unsigned u) { return __uint_as_float(u << 16); }
__device__ __forceinline__ float bfhi(unsigned u) { return __uint_as_float(u & 0xffff0000u); }
__device__ __forceinline__ float fexp2(float x) { return __builtin_amdgcn_exp2f(x); }
__device__ __forceinline__ float silu_f(float x) { return x / (1.f + __expf(-x)); }
__device__ __forceinline__ float wsum64(float v) {
#pragma unroll
  for (int o = 32; o >= 1; o >>= 1) v += __shfl_xor(v, o);
  return v;
}
#define DPPF(v, ctrl) __int_as_float(__builtin_amdgcn_update_dpp(0, __float_as_int(v), ctrl, 0xF, 0xF, true))
__device__ __forceinline__ float gsum16(float v) {
  v += DPPF(v, 0xB1); v += DPPF(v, 0x4E); v += DPPF(v, 0x141); v += DPPF(v, 0x140);
  return v;
}
__device__ __forceinline__ float gmax16(float v) {
  v = fmaxf(v, DPPF(v, 0xB1)); v = fmaxf(v, DPPF(v, 0x4E)); v = fmaxf(v, DPPF(v, 0x141)); v = fmaxf(v, DPPF(v, 0x140));
  return v;
}
__device__ __forceinline__ void wave_lds_sync() {
  __builtin_amdgcn_fence(__ATOMIC_RELEASE, "workgroup");
  __builtin_amdgcn_wave_barrier();
  __builtin_amdgcn_fence(__ATOMIC_ACQUIRE, "workgroup");
}
__device__ __forceinline__ f32x4 mfma16(bf16x8 a, bf16x8 b, f32x4 c) {
  return __builtin_amdgcn_mfma_f32_16x16x32_bf16(a, b, c, 0, 0, 0);
}
__device__ __forceinline__ bf16x8 ld8(const u16* p) { return *reinterpret_cast<const bf16x8*>(p); }

__device__ __forceinline__ float ret_lg2(const Params& p, int l, int dir, int h) {
  float x = p.ret_logit[(l * 2 + dir) * 4 + h];
  return -log1pf(expf(-x)) * LOG2E;
}
__device__ __forceinline__ float hgrn_lb(const Params& p, int l, int dir, int ch256) {
  float a0 = p.lb_logit[(0 * 2 + dir) * 256 + ch256], a1 = p.lb_logit[(1 * 2 + dir) * 256 + ch256];
  float a2 = p.lb_logit[(2 * 2 + dir) * 256 + ch256], a3 = p.lb_logit[(3 * 2 + dir) * 256 + ch256];
  float mx = fmaxf(fmaxf(a0, a1), fmaxf(a2, a3));
  float e0 = expf(a0 - mx), e1 = expf(a1 - mx), e2 = expf(a2 - mx), e3 = expf(a3 - mx);
  float inv = 1.f / (e0 + e1 + e2 + e3);
  float s = 0.f;
  if (l >= 1) s += e1;
  if (l >= 2) s += e2;
  if (l >= 3) s += e3;
  return s * inv;
}

__device__ void adaln_item(const Params& p, int it, unsigned char* smem) {
  float* sv = (float*)smem;
  float* red = sv + 9 * 1024;
  const int tid = otid(), w = tid >> 6, lane = tid & 63;
  const int l = it / 48, cb = (it % 48) * 64;
  __syncthreads();
  for (int i = tid; i < 9 * 1024; i += 256) {
    int v = i >> 10, k = i & 1023;
    float cv = v < 8 ? p.c[v * 1024 + k] : p.c_ctx[k];
    sv[i] = cv / (1.f + expf(-cv));
  }
  __syncthreads();
  const int col = cb + lane;
  const float* W = p.w_ada + (size_t)l * 1024 * 3072 + col;
  float acc[9];
#pragma unroll
  for (int v = 0; v < 9; ++v) acc[v] = 0.f;
#pragma unroll 1
  for (int k0 = w * 256; k0 < w * 256 + 256; k0 += 16) {
    float wv[16];
#pragma unroll
    for (int i = 0; i < 16; ++i) wv[i] = W[(size_t)(k0 + i) * 3072];
#pragma unroll
    for (int i = 0; i < 16; ++i)
#pragma unroll
      for (int v = 0; v < 9; ++v) acc[v] += sv[v * 1024 + k0 + i] * wv[i];
  }
#pragma unroll
  for (int v = 0; v < 9; ++v) red[(w * 9 + v) * 64 + lane] = acc[v];
  __syncthreads();
  if (tid < 64) {
    float bb = p.b_ada[l * 3072 + col];
#pragma unroll
    for (int v = 0; v < 9; ++v) {
      float s = red[(0 * 9 + v) * 64 + lane] + red[(1 * 9 + v) * 64 + lane] + red[(2 * 9 + v) * 64 + lane] + red[(3 * 9 + v) * 64 + lane];
      p.mod[(l * 9 + v) * 3072 + col] = s + bb;
    }
  }
  __syncthreads();
}

__device__ void rope_item(const Params& p, int it) {
  int idx = it * 256 + otid();
  int s = idx >> 5, i = idx & 31, fi = i & 15;
  float freq = powf(10000.f, -(float)fi / 16.f);
  int pos = (i < 16) ? (s >> 6) : (s & 63);
  float ang = (float)pos * freq;
  p.rope[idx * 2] = cosf(ang);
  p.rope[idx * 2 + 1] = sinf(ang);
}

__device__ void conv_tile(const float* src, int N, u16* dst, int tile, unsigned char* smem) {
  float* t = (float*)smem;
  const int tid = otid();
  const int ntn = N >> 6;
  const int k0 = (tile / ntn) * 64, n0 = (tile % ntn) * 64;
  __syncthreads();
#pragma unroll
  for (int r = 0; r < 16; ++r) {
    int row = r * 4 + (tid >> 6), col = tid & 63;
    t[row * 65 + col] = src[(size_t)(k0 + row) * N + n0 + col];
  }
  __syncthreads();
#pragma unroll
  for (int r = 0; r < 8; ++r) {
    int n = r * 8 + (tid >> 5), kp = tid & 31;
    unsigned v = pack2(t[(2 * kp) * 65 + n], t[(2 * kp + 1) * 65 + n]);
    *reinterpret_cast<unsigned*>(dst + (size_t)(n0 + n) * WS + k0 + 2 * kp) = v;
  }
  __syncthreads();
}


__device__ void cache_conv_item(const Params& p, int l, int it) {
  const int tid = otid();
  const float* src; u16* dst; int W, e0;
  if (it < 128) { src = p.cwk; dst = p.cbak; W = 128; e0 = it * 2048; }
  else if (it < 256) { src = p.cwv; dst = p.cbav; W = 128; e0 = (it - 128) * 2048; }
  else if (it < 512) { src = p.cnk; dst = p.cbbk; W = 256; e0 = (it - 256) * 2048; }
  else { src = p.cnv; dst = p.cbbv; W = 256; e0 = (it - 512) * 2048; }
  const int e = e0 + tid * 8;
  const int per_b = 256 * W, b = e / per_b, r = e - b * per_b;
  const float* sp = src + (size_t)((b * 4 + l) * 256) * W + r;
  float4 a = *reinterpret_cast<const float4*>(sp), c = *reinterpret_cast<const float4*>(sp + 4);
  uint4 o;
  o.x = pack2(a.x, a.y); o.y = pack2(a.z, a.w); o.z = pack2(c.x, c.y); o.w = pack2(c.z, c.w);
  *reinterpret_cast<uint4*>(dst + e) = o;
}
struct PrepRow { float4 x[4]; uint2 y[4]; float4 g[4], sh[4], sc[4]; };
__device__ __forceinline__ void prep_issue(const Params& p, int l, int T, int lane, PrepRow& r) {
  const int v = T < NCTX ? 8 : ((T - NCTX) >> 11);
  const float* xin = (l <= 1) ? (T < NCTX ? p.x_prompt + (size_t)T * 1024 : p.x_sample + (size_t)(T - NCTX) * 1024)
                              : p.out + (size_t)T * 1024;
#pragma unroll
  for (int i = 0; i < 4; ++i) r.x[i] = *reinterpret_cast<const float4*>(xin + (i * 64 + lane) * 4);
  if (l > 0) {
    const u16* yr = p.ybuf + (size_t)T * 1024;
    const float* gate = p.mod + ((l - 1) * 9 + v) * 3072 + 2048;
#pragma unroll
    for (int i = 0; i < 4; ++i) {
      const int col = (i * 64 + lane) * 4;
      r.y[i] = *reinterpret_cast<const uint2*>(yr + col);
      r.g[i] = *reinterpret_cast<const float4*>(gate + col);
    }
  }
  if (l < 4) {
    const float* md = p.mod + (l * 9 + v) * 3072;
#pragma unroll
    for (int i = 0; i < 4; ++i) {
      const int col = (i * 64 + lane) * 4;
      r.sh[i] = *reinterpret_cast<const float4*>(md + col);
      r.sc[i] = *reinterpret_cast<const float4*>(md + 1024 + col);
    }
  }
}
template <int DRY>
__device__ void prep_phase(const Params& p, int l, int bid, int nb) {
  const int tid = otid(), w = tid >> 6, lane = tid & 63;
  const int tstep = nb * 4;
  int T = bid * 4 + w;
  if (T >= NTOK) return;
  float4 pq[4], pgp[4];
#pragma unroll
  for (int i = 0; i < 4; ++i) {
    const int col = (i * 64 + lane) * 4;
    if (l > 0) pq[i] = *reinterpret_cast<const float4*>(p.g_post + (l - 1) * 1024 + col);
    if (l < 4) pgp[i] = *reinterpret_cast<const float4*>(p.g_pre + l * 1024 + col);
  }
  PrepRow cur, nxt;
  prep_issue(p, l, T, lane, nxt);
#pragma unroll 1
  for (; T < NTOK; T += tstep) {
    cur = nxt;
    if (T + tstep < NTOK) prep_issue(p, l, T + tstep, lane, nxt);
    float4 xv[4];
#pragma unroll
    for (int i = 0; i < 4; ++i) xv[i] = cur.x[i];
    if (l > 0) {
      float4 yv[4];
      float ss = 0.f;
#pragma unroll
      for (int i = 0; i < 4; ++i) {
        yv[i] = make_float4(bflo(cur.y[i].x), bfhi(cur.y[i].x), bflo(cur.y[i].y), bfhi(cur.y[i].y));
        ss += yv[i].x * yv[i].x + yv[i].y * yv[i].y + yv[i].z * yv[i].z + yv[i].w * yv[i].w;
      }
      ss = wsum64(ss);
      const float rstd = rsqrtf(ss * (1.f / 1024.f) + 1e-6f);
#pragma unroll
      for (int i = 0; i < 4; ++i) {
        const int col = (i * 64 + lane) * 4;
        xv[i].x += cur.g[i].x * (yv[i].x * rstd * pq[i].x);
        xv[i].y += cur.g[i].y * (yv[i].y * rstd * pq[i].y);
        xv[i].z += cur.g[i].z * (yv[i].z * rstd * pq[i].z);
        xv[i].w += cur.g[i].w * (yv[i].w * rstd * pq[i].w);
        if (!DRY) *reinterpret_cast<float4*>(p.out + (size_t)T * 1024 + col) = xv[i];
      }
    }
    if (l < 4) {
      float ss = 0.f;
#pragma unroll
      for (int i = 0; i < 4; ++i) ss += xv[i].x * xv[i].x + xv[i].y * xv[i].y + xv[i].z * xv[i].z + xv[i].w * xv[i].w;
      ss = wsum64(ss);
      const float rstd = rsqrtf(ss * (1.f / 1024.f) + 1e-6f);
#pragma unroll
      for (int i = 0; i < 4; ++i) {
        const int col = (i * 64 + lane) * 4;
        const float h0 = xv[i].x * rstd * pgp[i].x * (1.f + cur.sc[i].x) + cur.sh[i].x;
        const float h1 = xv[i].y * rstd * pgp[i].y * (1.f + cur.sc[i].y) + cur.sh[i].y;
        const float h2 = xv[i].z * rstd * pgp[i].z * (1.f + cur.sc[i].z) + cur.sh[i].z;
        const float h3 = xv[i].w * rstd * pgp[i].w * (1.f + cur.sc[i].w) + cur.sh[i].w;
        uint2 o;
        o.x = pack2(h0, h1);
        o.y = pack2(h2, h3);
        *reinterpret_cast<uint2*>(p.hbuf + (size_t)T * HS + col) = o;
      }
    }
  }
}

template <int MODE>
__device__ void gemm_tile(const Params& p, int l, int tile, unsigned char* smem) {
  u16* As = (u16*)smem;
  u16* Bs = As + 128 * 72;
  const int tid = otid(), w = tid >> 6, lane = tid & 63, r16 = lane & 15, quad = lane >> 4;
  const int wr = w >> 1, wc = w & 1;
  const int ntn = (MODE == 0) ? 32 : 8;
  const int ntm = (MODE == 0) ? 160 : 160;
  const int tm = tile % ntm, tn = tile / ntm;
  const u16* Agp = p.hbuf + (size_t)(tm * 128) * HS;
  const u16* Bgp = ((MODE == 0) ? p.wt_in : p.wt_out) + (size_t)(tn * 128) * WS;
  f32x4 acc[4][4];
#pragma unroll
  for (int a = 0; a < 4; ++a)
#pragma unroll
    for (int b = 0; b < 4; ++b) acc[a][b] = (f32x4){0.f, 0.f, 0.f, 0.f};
  const int lrow = tid >> 3, lkc = (tid & 7) * 8;
  const unsigned voff_Agp = lrow * HS + lkc, voff_Bgp = lrow * WS + lkc;
  u16* Asp = As + lrow * 72 + lkc;
  u16* Bsp = Bs + lrow * 72 + lkc;
  uint4 ra0, ra1, ra2, ra3, rb0, rb1, rb2, rb3;
#define GLD(p_, r_, S_) *reinterpret_cast<const uint4*>((p_) + ((size_t)(r_) * 32 * S_ + kofs) + voff_##p_)
#define GLOAD(KO) { const int kofs = (KO); \
  ra0 = GLD(Agp, 0, HS); ra1 = GLD(Agp, 1, HS); ra2 = GLD(Agp, 2, HS); ra3 = GLD(Agp, 3, HS); \
  rb0 = GLD(Bgp, 0, WS); rb1 = GLD(Bgp, 1, WS); rb2 = GLD(Bgp, 2, WS); rb3 = GLD(Bgp, 3, WS); }
#define SST(p_, st_, r_, v_) *reinterpret_cast<uint4*>((p_) + (st_) * (2 * 128 * 72) + (r_) * 32 * 72) = v_
#define STORE(st_) { SST(Asp, st_, 0, ra0); SST(Asp, st_, 1, ra1); SST(Asp, st_, 2, ra2); SST(Asp, st_, 3, ra3); \
                     SST(Bsp, st_, 0, rb0); SST(Bsp, st_, 1, rb1); SST(Bsp, st_, 2, rb2); SST(Bsp, st_, 3, rb3); }
  __syncthreads();
  GLOAD(0)
  STORE(0)
  GLOAD(64)
  __syncthreads();
#pragma unroll 1
  for (int kt = 0; kt < 16; ++kt) {
    const int cur = kt & 1;
    if (kt + 1 < 16) STORE(cur ^ 1)
    if (kt + 2 < 16) GLOAD((kt + 2) * 64)
    const u16* Ac = As + cur * (2 * 128 * 72);
    const u16* Bc = Bs + cur * (2 * 128 * 72);
    __builtin_amdgcn_s_setprio(1);
#pragma unroll
    for (int ks = 0; ks < 2; ++ks) {
      bf16x8 wf[4], xf[4];
#pragma unroll
      for (int i = 0; i < 4; ++i) {
        wf[i] = ld8(Bc + (wc * 64 + i * 16 + r16) * 72 + ks * 32 + quad * 8);
        xf[i] = ld8(Ac + (wr * 64 + i * 16 + r16) * 72 + ks * 32 + quad * 8);
      }
#pragma unroll
      for (int nt = 0; nt < 4; ++nt)
#pragma unroll
        for (int mt = 0; mt < 4; ++mt) acc[nt][mt] = mfma16(wf[nt], xf[mt], acc[nt][mt]);
    }
    __builtin_amdgcn_s_setprio(0);
    __syncthreads();
  }
#undef GLD
#undef GLOAD
#undef SST
#undef STORE
  const int colbase = tn * 128 + wc * 64;
  if (MODE == 0) {
    const bool ropeseg = (colbase < 384) || (colbase >= 1792 && colbase < 2304);
#pragma unroll
    for (int mt = 0; mt < 4; ++mt) {
      const int T = tm * 128 + wr * 64 + mt * 16 + r16;
      const bool lat = T >= NCTX;
      if (ropeseg && lat) {
        const int s = (T - NCTX) & 2047;
        const float* rp = p.rope + (size_t)(s * 32 + quad * 4) * 2;
        float4 c0 = *reinterpret_cast<const float4*>(rp);
        float4 c1 = *reinterpret_cast<const float4*>(rp + 4);
        float4 d0 = *reinterpret_cast<const float4*>(rp + 32);
        float4 d1 = *reinterpret_cast<const float4*>(rp + 36);
        float cs[4] = {c0.x, c0.z, c1.x, c1.z}, sn[4] = {c0.y, c0.w, c1.y, c1.w};
        float cs2[4] = {d0.x, d0.z, d1.x, d1.z}, sn2[4] = {d0.y, d0.w, d1.y, d1.w};
#pragma unroll
        for (int j = 0; j < 4; ++j) {
          float x1 = acc[0][mt][j], x2 = acc[1][mt][j];
          acc[0][mt][j] = x1 * cs[j] - x2 * sn[j];
          acc[1][mt][j] = x2 * cs[j] + x1 * sn[j];
          float y1 = acc[2][mt][j], y2 = acc[3][mt][j];
          acc[2][mt][j] = y1 * cs2[j] - y2 * sn2[j];
          acc[3][mt][j] = y2 * cs2[j] + y1 * sn2[j];
        }
      }
#pragma unroll
      for (int nt = 0; nt < 4; ++nt) {
        const int col = colbase + nt * 16 + quad * 4;
        uint2 o;
        o.x = pack2(acc[nt][mt][0], acc[nt][mt][1]);
        o.y = pack2(acc[nt][mt][2], acc[nt][mt][3]);
        *reinterpret_cast<uint2*>(p.proj + (size_t)T * 4096 + col) = o;
        if (!lat) {
          const int b = T >> 8, s = T & 255;
          float4 f = {acc[nt][mt][0], acc[nt][mt][1], acc[nt][mt][2], acc[nt][mt][3]};
          const size_t rowi = (size_t)((b * 4 + l) * 256 + s);
          if (col >= 256 && col < 384) *reinterpret_cast<float4*>(p.out + OUT_WK + rowi * 128 + (col - 256)) = f;
          else if (col >= 384 && col < 512) *reinterpret_cast<float4*>(p.out + OUT_WV + rowi * 128 + (col - 384)) = f;
          else if (col >= 1024 && col < 1280) *reinterpret_cast<float4*>(p.out + OUT_NK + rowi * 256 + (col - 1024)) = f;
          else if (col >= 1280 && col < 1536) *reinterpret_cast<float4*>(p.out + OUT_NV + rowi * 256 + (col - 1280)) = f;
        }
      }
    }
  } else {
#pragma unroll
    for (int mt = 0; mt < 4; ++mt) {
      const int T = tm * 128 + wr * 64 + mt * 16 + r16;
#pragma unroll
      for (int nt = 0; nt < 4; ++nt) {
        const int col = colbase + nt * 16 + quad * 4;
        uint2 o;
        o.x = pack2(acc[nt][mt][0], acc[nt][mt][1]);
        o.y = pack2(acc[nt][mt][2], acc[nt][mt][3]);
        *reinterpret_cast<uint2*>(p.ybuf + (size_t)T * 1024 + col) = o;
      }
    }
  }
}

__device__ void gemm_out(const Params& p, int tile, unsigned char* smem) {
  u16* As = (u16*)smem;
  u16* Bs = As + 160 * 72;
  const int tid = otid(), w = tid >> 6, lane = tid & 63, r16 = lane & 15, quad = lane >> 4;
  const int wr = w >> 1, wc = w & 1;
  const int tm = tile & 127, tn = tile >> 7;
  const u16* Agp = p.hbuf + (size_t)(tm * 160) * HS;
  const u16* Bgp = p.wt_out + (size_t)(tn * 128) * WS;
  f32x4 acc[4][5];
#pragma unroll
  for (int a = 0; a < 4; ++a)
#pragma unroll
    for (int b = 0; b < 5; ++b) acc[a][b] = (f32x4){0.f, 0.f, 0.f, 0.f};
  const int lrow = tid >> 3, lkc = (tid & 7) * 8;
  const unsigned voff_Agp = lrow * HS + lkc, voff_Bgp = lrow * WS + lkc;
  u16* Asp = As + lrow * 72 + lkc;
  u16* Bsp = Bs + lrow * 72 + lkc;
  uint4 ra0, ra1, ra2, ra3, ra4, rb0, rb1, rb2, rb3;
#define GLD(p_, r_, S_) *reinterpret_cast<const uint4*>((p_) + ((size_t)(r_) * 32 * S_ + kofs) + voff_##p_)
#define GLOADO(KO) { const int kofs = (KO); \
  ra0 = GLD(Agp, 0, HS); ra1 = GLD(Agp, 1, HS); ra2 = GLD(Agp, 2, HS); ra3 = GLD(Agp, 3, HS); ra4 = GLD(Agp, 4, HS); \
  rb0 = GLD(Bgp, 0, WS); rb1 = GLD(Bgp, 1, WS); rb2 = GLD(Bgp, 2, WS); rb3 = GLD(Bgp, 3, WS); }
#define SST(p_, r_, v_) *reinterpret_cast<uint4*>((p_) + (r_) * 32 * 72) = v_
  GLOADO(0)
#pragma unroll 1
  for (int kt = 0; kt < 16; ++kt) {
    __syncthreads();
    SST(Asp, 0, ra0); SST(Asp, 1, ra1); SST(Asp, 2, ra2); SST(Asp, 3, ra3); SST(Asp, 4, ra4);
    SST(Bsp, 0, rb0); SST(Bsp, 1, rb1); SST(Bsp, 2, rb2); SST(Bsp, 3, rb3);
    if (kt + 1 < 16) GLOADO((kt + 1) * 64)
    __syncthreads();
    {
      bf16x8 wf0[4], xf0[5], wf1[4], xf1[5];
#pragma unroll
      for (int i = 0; i < 4; ++i) wf0[i] = ld8(Bs + (wc * 64 + i * 16 + r16) * 72 + quad * 8);
#pragma unroll
      for (int i = 0; i < 5; ++i) xf0[i] = ld8(As + (wr * 80 + i * 16 + r16) * 72 + quad * 8);
#pragma unroll
      for (int i = 0; i < 4; ++i) wf1[i] = ld8(Bs + (wc * 64 + i * 16 + r16) * 72 + 32 + quad * 8);
#pragma unroll
      for (int i = 0; i < 5; ++i) xf1[i] = ld8(As + (wr * 80 + i * 16 + r16) * 72 + 32 + quad * 8);
      __builtin_amdgcn_sched_barrier(0);
      __builtin_amdgcn_s_setprio(1);
#pragma unroll
      for (int mt = 0; mt < 5; ++mt)
#pragma unroll
        for (int nt = 0; nt < 4; ++nt) acc[nt][mt] = mfma16(wf0[nt], xf0[mt], acc[nt][mt]);
#pragma unroll
      for (int mt = 0; mt < 5; ++mt)
#pragma unroll
        for (int nt = 0; nt < 4; ++nt) acc[nt][mt] = mfma16(wf1[nt], xf1[mt], acc[nt][mt]);
      __builtin_amdgcn_s_setprio(0);
    }
  }
#undef GLD
#undef GLOADO
#undef SST
  const int colbase = tn * 128 + wc * 64;
#pragma unroll
  for (int mt = 0; mt < 5; ++mt) {
    const int T = tm * 160 + wr * 80 + mt * 16 + r16;
#pragma unroll
    for (int nt = 0; nt < 4; ++nt) {
      const int col = colbase + nt * 16 + quad * 4;
      uint2 o;
      o.x = pack2(acc[nt][mt][0], acc[nt][mt][1]);
      o.y = pack2(acc[nt][mt][2], acc[nt][mt][3]);
      *reinterpret_cast<uint2*>(p.ybuf + (size_t)T * 1024 + col) = o;
    }
  }
}

__device__ void gemm_big(const Params& p, int l, int tile, unsigned char* smem) {
  u16* As = (u16*)smem;
  u16* Bs = As + 256 * 72;
  const int tid = otid(), w = tid >> 6, lane = tid & 63, r16 = lane & 15, quad = lane >> 4;
  const int wr = w >> 1, wc = w & 1;
  int tm, tn;
  {
    const int r = tile >> 9, x = tile & 7, sl = (tile & 511) >> 3;
    const int R = r * 8 + x;
    tm = (R % 10) * 8 + (sl & 7);
    tn = (R / 10) * 8 + (sl >> 3);
  }
  const u16* Ag = p.hbuf + (size_t)(tm * 256) * HS;
  const u16* Bg = p.wt_in + (size_t)(tn * 128) * WS;
  f32x4 acc[4][8];
#pragma unroll
  for (int a = 0; a < 4; ++a)
#pragma unroll
    for (int b = 0; b < 8; ++b) acc[a][b] = (f32x4){0.f, 0.f, 0.f, 0.f};
  const int lrow = tid >> 3, lkc = (tid & 7) * 8;
  const u16* Agp = Ag + (size_t)lrow * HS + lkc;
  const u16* Bgp = Bg + (size_t)lrow * WS + lkc;
  u16* Asp = As + lrow * 72 + lkc;
  u16* Bsp = Bs + lrow * 72 + lkc;
  uint4 ra0, ra1, ra2, ra3, ra4, ra5, ra6, ra7, rb0, rb1, rb2, rb3;
#define GLD(p_, r_, S_) *reinterpret_cast<const uint4*>((p_) + (size_t)(r_) * 32 * S_ + kofs)
#define GLOADB(KO) { const int kofs = (KO); \
  ra0 = GLD(Agp, 0, HS); ra1 = GLD(Agp, 1, HS); ra2 = GLD(Agp, 2, HS); ra3 = GLD(Agp, 3, HS); ra4 = GLD(Agp, 4, HS); ra5 = GLD(Agp, 5, HS); ra6 = GLD(Agp, 6, HS); ra7 = GLD(Agp, 7, HS); \
  rb0 = GLD(Bgp, 0, WS); rb1 = GLD(Bgp, 1, WS); rb2 = GLD(Bgp, 2, WS); rb3 = GLD(Bgp, 3, WS); }
#define SST(p_, r_, v_) *reinterpret_cast<uint4*>((p_) + (r_) * 32 * 72) = v_
  GLOADB(0)
#pragma unroll 1
  for (int kt = 0; kt < 16; ++kt) {
    __syncthreads();
    SST(Asp, 0, ra0); SST(Asp, 1, ra1); SST(Asp, 2, ra2); SST(Asp, 3, ra3); SST(Asp, 4, ra4); SST(Asp, 5, ra5); SST(Asp, 6, ra6); SST(Asp, 7, ra7);
    SST(Bsp, 0, rb0); SST(Bsp, 1, rb1); SST(Bsp, 2, rb2); SST(Bsp, 3, rb3);
    if (kt + 1 < 16) GLOADB((kt + 1) * 64)
    __syncthreads();
    {
      const u16* Bb = Bs + (wc * 64 + r16) * 72 + quad * 8;
      const u16* Ab = As + (wr * 128 + r16) * 72 + quad * 8;
      bf16x8 wf0[4], wf1[4], xr[3];
#pragma unroll
      for (int i = 0; i < 4; ++i) wf0[i] = ld8(Bb + i * 16 * 72);
#pragma unroll
      for (int i = 0; i < 2; ++i) xr[i] = ld8(Ab + i * 16 * 72);
#pragma unroll
      for (int i = 0; i < 4; ++i) wf1[i] = ld8(Bb + i * 16 * 72 + 32);
      __builtin_amdgcn_sched_barrier(0);
      __builtin_amdgcn_s_setprio(1);
#pragma unroll
      for (int st = 0; st < 16; ++st) {
        const int nx = st + 2;
        if (nx < 16) xr[nx % 3] = ld8(Ab + (nx & 7) * 16 * 72 + (nx >> 3) * 32);
        __builtin_amdgcn_sched_barrier(0);
        const int mt = st & 7;
        if (st < 8) {
#pragma unroll
          for (int nt = 0; nt < 4; ++nt) acc[nt][mt] = mfma16(wf0[nt], xr[st % 3], acc[nt][mt]);
        } else {
#pragma unroll
          for (int nt = 0; nt < 4; ++nt) acc[nt][mt] = mfma16(wf1[nt], xr[st % 3], acc[nt][mt]);
        }
        __builtin_amdgcn_sched_barrier(0);
      }
      __builtin_amdgcn_s_setprio(0);
    }
  }
#undef GLD
#undef GLOADB
#undef SST
  const int colbase = tn * 128 + wc * 64;
  const bool ropeseg = (colbase < 384) || (colbase >= 1792 && colbase < 2304);
  __syncthreads();
  u16* stg = (u16*)smem + w * (64 * 72);
#pragma unroll
  for (int half = 0; half < 2; ++half) {
#pragma unroll
    for (int mtl = 0; mtl < 4; ++mtl) {
      const int mt = half * 4 + mtl;
      const int T = tm * 256 + wr * 128 + mt * 16 + r16;
      const bool lat = T >= NCTX;
      if (ropeseg && lat) {
        const int s = (T - NCTX) & 2047;
        const float* rp = p.rope + (size_t)(s * 32 + quad * 4) * 2;
        float4 c0 = *reinterpret_cast<const float4*>(rp);
        float4 c1 = *reinterpret_cast<const float4*>(rp + 4);
        float4 d0 = *reinterpret_cast<const float4*>(rp + 32);
        float4 d1 = *reinterpret_cast<const float4*>(rp + 36);
        float cs[4] = {c0.x, c0.z, c1.x, c1.z}, sn[4] = {c0.y, c0.w, c1.y, c1.w};
        float cs2[4] = {d0.x, d0.z, d1.x, d1.z}, sn2[4] = {d0.y, d0.w, d1.y, d1.w};
#pragma unroll
        for (int j = 0; j < 4; ++j) {
          float x1 = acc[0][mt][j], x2 = acc[1][mt][j];
          acc[0][mt][j] = x1 * cs[j] - x2 * sn[j];
          acc[1][mt][j] = x2 * cs[j] + x1 * sn[j];
          float y1 = acc[2][mt][j], y2 = acc[3][mt][j];
          acc[2][mt][j] = y1 * cs2[j] - y2 * sn2[j];
          acc[3][mt][j] = y2 * cs2[j] + y1 * sn2[j];
        }
      }
#pragma unroll
      for (int nt = 0; nt < 4; ++nt) {
        uint2 o;
        o.x = pack2(acc[nt][mt][0], acc[nt][mt][1]);
        o.y = pack2(acc[nt][mt][2], acc[nt][mt][3]);
        *reinterpret_cast<uint2*>(stg + (mtl * 16 + r16) * 72 + nt * 16 + quad * 4) = o;
        if (!lat) {
          const int col = colbase + nt * 16 + quad * 4;
          const int b = T >> 8, s = T & 255;
          float4 f = {acc[nt][mt][0], acc[nt][mt][1], acc[nt][mt][2], acc[nt][mt][3]};
          const size_t rowi = (size_t)((b * 4 + l) * 256 + s);
          if (col >= 256 && col < 384) *reinterpret_cast<float4*>(p.out + OUT_WK + rowi * 128 + (col - 256)) = f;
          else if (col >= 384 && col < 512) *reinterpret_cast<float4*>(p.out + OUT_WV + rowi * 128 + (col - 384)) = f;
          else if (col >= 1024 && col < 1280) *reinterpret_cast<float4*>(p.out + OUT_NK + rowi * 256 + (col - 1024)) = f;
          else if (col >= 1280 && col < 1536) *reinterpret_cast<float4*>(p.out + OUT_NV + rowi * 256 + (col - 1280)) = f;
        }
      }
    }
    wave_lds_sync();
#pragma unroll
    for (int i = 0; i < 8; ++i) {
      const int row = i * 8 + (lane >> 3), ch = lane & 7;
      uint4 v = *reinterpret_cast<const uint4*>(stg + row * 72 + ch * 8);
      const int T = tm * 256 + wr * 128 + half * 64 + row;
      *reinterpret_cast<uint4*>(p.proj + (size_t)T * 4096 + colbase + ch * 8) = v;
    }
    wave_lds_sync();
  }
}

__device__ __forceinline__ void ld_rows_bf16(u16* dst, const u16* src, size_t stride) {
  const int tid = otid(), row = tid >> 2, part = (tid & 3) * 16;
  const u16* s = src + (size_t)row * stride + part;
  uint4 a = *reinterpret_cast<const uint4*>(s);
  uint4 b = *reinterpret_cast<const uint4*>(s + 8);
  *reinterpret_cast<uint4*>(dst + row * 72 + part) = a;
  *reinterpret_cast<uint4*>(dst + row * 72 + part + 8) = b;
}
__device__ __forceinline__ void ld_rows_f32(u16* dst, const float* src, size_t stride) {
  const int tid = otid(), row = tid >> 2, part = (tid & 3) * 16;
  const float* s = src + (size_t)row * stride + part;
  float4 a = *reinterpret_cast<const float4*>(s), b = *reinterpret_cast<const float4*>(s + 4);
  float4 c = *reinterpret_cast<const float4*>(s + 8), d = *reinterpret_cast<const float4*>(s + 12);
  uint4 o0, o1;
  o0.x = pack2(a.x, a.y); o0.y = pack2(a.z, a.w); o0.z = pack2(b.x, b.y); o0.w = pack2(b.z, b.w);
  o1.x = pack2(c.x, c.y); o1.y = pack2(c.z, c.w); o1.z = pack2(d.x, d.y); o1.w = pack2(d.z, d.w);
  *reinterpret_cast<uint4*>(dst + row * 72 + part) = o0;
  *reinterpret_cast<uint4*>(dst + row * 72 + part + 8) = o1;
}
__device__ __forceinline__ void ld_tr_bf16(u16* dst, const u16* src, size_t stride) {
  const int tid = otid(), dc = tid >> 5, kp = tid & 31;
  uint4 a = *reinterpret_cast<const uint4*>(src + (size_t)(2 * kp) * stride + dc * 8);
  uint4 b = *reinterpret_cast<const uint4*>(src + (size_t)(2 * kp + 1) * stride + dc * 8);
  unsigned av[4] = {a.x, a.y, a.z, a.w}, bv[4] = {b.x, b.y, b.z, b.w};
#pragma unroll
  for (int i = 0; i < 4; ++i) {
    unsigned lo = (av[i] & 0xffffu) | (bv[i] << 16);
    unsigned hi = (av[i] >> 16) | (bv[i] & 0xffff0000u);
    *reinterpret_cast<unsigned*>(dst + (dc * 8 + 2 * i) * 72 + 2 * kp) = lo;
    *reinterpret_cast<unsigned*>(dst + (dc * 8 + 2 * i + 1) * 72 + 2 * kp) = hi;
  }
}
__device__ __forceinline__ void ld_tr_f32(u16* dst, const float* src, size_t stride) {
  const int tid = otid(), dc = tid >> 5, kp = tid & 31;
  const float* s0 = src + (size_t)(2 * kp) * stride + dc * 8;
  const float* s1 = src + (size_t)(2 * kp + 1) * stride + dc * 8;
  float4 a0 = *reinterpret_cast<const float4*>(s0), a1 = *reinterpret_cast<const float4*>(s0 + 4);
  float4 b0 = *reinterpret_cast<const float4*>(s1), b1 = *reinterpret_cast<const float4*>(s1 + 4);
  float av[8] = {a0.x, a0.y, a0.z, a0.w, a1.x, a1.y, a1.z, a1.w};
  float bv[8] = {b0.x, b0.y, b0.z, b0.w, b1.x, b1.y, b1.z, b1.w};
#pragma unroll
  for (int i = 0; i < 8; ++i) *reinterpret_cast<unsigned*>(dst + (dc * 8 + i) * 72 + 2 * kp) = pack2(av[i], bv[i]);
}

#define DEFER_THR 10.0f
template <int NSUB, class F>
__device__ __forceinline__ void attn_step(const u16* Ksh, const u16* Vt, int kbeg, const bf16x8 (&aq)[2],
                                          f32x4 (&o)[4], float& m, float& ls, F maskf, int r16, int quad) {
  f32x4 st[NSUB];
  __builtin_amdgcn_s_setprio(1);
#pragma unroll
  for (int t = 0; t < NSUB; ++t) {
    st[t] = (f32x4){0.f, 0.f, 0.f, 0.f};
#pragma unroll
    for (int ks = 0; ks < 2; ++ks) st[t] = mfma16(ld8(Ksh + (kbeg + t * 16 + r16) * 72 + ks * 32 + quad * 8), aq[ks], st[t]);
  }
  __builtin_amdgcn_s_setprio(0);
  float mx = -1e30f;
#pragma unroll
  for (int t = 0; t < NSUB; ++t)
#pragma unroll
    for (int j = 0; j < 4; ++j) {
      st[t][j] = maskf(kbeg + t * 16 + quad * 4 + j, st[t][j] * (0.125f * LOG2E));
      mx = fmaxf(mx, st[t][j]);
    }
  mx = fmaxf(mx, __shfl_xor(mx, 16));
  mx = fmaxf(mx, __shfl_xor(mx, 32));
  float al = 1.f;
  __builtin_amdgcn_sched_barrier(0);
  if (__any(mx - m > DEFER_THR)) {
    const float mn = fmaxf(m, mx);
    al = fexp2(m - mn);
    m = mn;
#pragma unroll
    for (int n = 0; n < 4; ++n)
#pragma unroll
      for (int j = 0; j < 4; ++j) o[n][j] *= al;
  }
  __builtin_amdgcn_sched_barrier(0);
  float rs = 0.f;
#pragma unroll
  for (int t = 0; t < NSUB; ++t)
#pragma unroll
    for (int j = 0; j < 4; ++j) {
      float pv = fexp2(st[t][j] - m);
      st[t][j] = pv;
      rs += pv;
    }
  ls = ls * al + rs;
  __builtin_amdgcn_s_setprio(1);
#pragma unroll
  for (int s2 = 0; s2 < NSUB / 2; ++s2) {
    union { unsigned u[4]; bf16x8 v; } bp;
    bp.u[0] = pack2(st[2 * s2][0], st[2 * s2][1]);
    bp.u[1] = pack2(st[2 * s2][2], st[2 * s2][3]);
    bp.u[2] = pack2(st[2 * s2 + 1][0], st[2 * s2 + 1][1]);
    bp.u[3] = pack2(st[2 * s2 + 1][2], st[2 * s2 + 1][3]);
#pragma unroll
    for (int n = 0; n < 4; ++n) {
      const u16* vp = Vt + (n * 16 + r16) * 72 + kbeg + s2 * 32 + quad * 4;
      union { uint2 h[2]; bf16x8 v; } av;
      av.h[0] = *reinterpret_cast<const uint2*>(vp);
      av.h[1] = *reinterpret_cast<const uint2*>(vp + 16);
      o[n] = mfma16(av.v, bp.v, o[n]);
    }
  }
  __builtin_amdgcn_s_setprio(0);
}

struct KVb { uint4 k0, k1, v0, v1; };
struct KVf { float4 k0, k1, k2, k3, v0, v1, v2, v3; };
__device__ __forceinline__ void kv_issue_b(uint4& rk0, uint4& rk1, uint4& rv0, uint4& rv1, const u16* ks, const u16* vs, size_t stride, int tid) {
  const int row = tid >> 2, part = (tid & 3) * 16;
  const u16* s = ks + (size_t)row * stride + part;
  rk0 = *reinterpret_cast<const uint4*>(s);
  rk1 = *reinterpret_cast<const uint4*>(s + 8);
  const int dc = tid >> 5, kp = tid & 31;
  rv0 = *reinterpret_cast<const uint4*>(vs + (size_t)(2 * kp) * stride + dc * 8);
  rv1 = *reinterpret_cast<const uint4*>(vs + (size_t)(2 * kp + 1) * stride + dc * 8);
}
__device__ __forceinline__ void kv_commit_b(const uint4& rk0, const uint4& rk1, const uint4& rv0, const uint4& rv1, u16* Ksh, u16* Vt, int tid) {
  const int row = tid >> 2, part = (tid & 3) * 16;
  *reinterpret_cast<uint4*>(Ksh + row * 72 + part) = rk0;
  *reinterpret_cast<uint4*>(Ksh + row * 72 + part + 8) = rk1;
  const int dc = tid >> 5, kp = tid & 31;
  unsigned av[4] = {rv0.x, rv0.y, rv0.z, rv0.w}, bv[4] = {rv1.x, rv1.y, rv1.z, rv1.w};
#pragma unroll
  for (int i = 0; i < 4; ++i) {
    unsigned lo = (av[i] & 0xffffu) | (bv[i] << 16);
    unsigned hi = (av[i] >> 16) | (bv[i] & 0xffff0000u);
    *reinterpret_cast<unsigned*>(Vt + (dc * 8 + 2 * i) * 72 + 2 * kp) = lo;
    *reinterpret_cast<unsigned*>(Vt + (dc * 8 + 2 * i + 1) * 72 + 2 * kp) = hi;
  }
}
__device__ __forceinline__ void kv_issue_f(float4& fk0, float4& fk1, float4& fk2, float4& fk3, float4& fv0, float4& fv1, float4& fv2, float4& fv3, const float* ks, const float* vs, size_t stride, int tid) {
  const int row = tid >> 2, part = (tid & 3) * 16;
  const float* s = ks + (size_t)row * stride + part;
  fk0 = *reinterpret_cast<const float4*>(s);
  fk1 = *reinterpret_cast<const float4*>(s + 4);
  fk2 = *reinterpret_cast<const float4*>(s + 8);
  fk3 = *reinterpret_cast<const float4*>(s + 12);
  const int dc = tid >> 5, kp = tid & 31;
  const float* s0 = vs + (size_t)(2 * kp) * stride + dc * 8;
  const float* s1 = vs + (size_t)(2 * kp + 1) * stride + dc * 8;
  fv0 = *reinterpret_cast<const float4*>(s0);
  fv1 = *reinterpret_cast<const float4*>(s0 + 4);
  fv2 = *reinterpret_cast<const float4*>(s1);
  fv3 = *reinterpret_cast<const float4*>(s1 + 4);
}
__device__ __forceinline__ void kv_commit_f(const float4& fk0, const float4& fk1, const float4& fk2, const float4& fk3, const float4& fv0, const float4& fv1, const float4& fv2, const float4& fv3, u16* Ksh, u16* Vt, int tid) {
  const int row = tid >> 2, part = (tid & 3) * 16;
  uint4 o0, o1;
  o0.x = pack2(fk0.x, fk0.y); o0.y = pack2(fk0.z, fk0.w); o0.z = pack2(fk1.x, fk1.y); o0.w = pack2(fk1.z, fk1.w);
  o1.x = pack2(fk2.x, fk2.y); o1.y = pack2(fk2.z, fk2.w); o1.z = pack2(fk3.x, fk3.y); o1.w = pack2(fk3.z, fk3.w);
  *reinterpret_cast<uint4*>(Ksh + row * 72 + part) = o0;
  *reinterpret_cast<uint4*>(Ksh + row * 72 + part + 8) = o1;
  const int dc = tid >> 5, kp = tid & 31;
  float av[8] = {fv0.x, fv0.y, fv0.z, fv0.w, fv1.x, fv1.y, fv1.z, fv1.w};
  float bv[8] = {fv2.x, fv2.y, fv2.z, fv2.w, fv3.x, fv3.y, fv3.z, fv3.w};
#pragma unroll
  for (int i = 0; i < 8; ++i) *reinterpret_cast<unsigned*>(Vt + (dc * 8 + i) * 72 + 2 * kp) = pack2(av[i], bv[i]);
}

template <int KIND>
__device__ void attn_item(const Params& p, int l, int it, unsigned char* smem) {
  u16* Ksh = (u16*)smem;
  u16* Vt = Ksh + 64 * 72;
  float* rpbs = (float*)(Vt + 64 * 72);
  const int tid = otid(), w = tid >> 6, lane = tid & 63, r16 = lane & 15, quad = lane >> 4;
  int b, h, qt, Tq0;
  if (KIND < 2) { b = it >> 3; h = (it >> 1) & 3; qt = it & 1; Tq0 = b * 256 + qt * 128; }
  else { b = it >> 6; h = (it >> 4) & 3; qt = it & 15; Tq0 = NCTX + b * 2048 + qt * 128; }
  const bool isA = (KIND == 0 || KIND == 2);
  const int qcol = isA ? 0 : 768, gcol = isA ? 512 : 1536, mixcol = isA ? 0 : 256;
  const int kv = h >> 1;
  int qoff[2];
  if (KIND == 3) { qoff[0] = (w >> 1) * 64 + (w & 1) * 32; qoff[1] = qoff[0] + 16; }
  else { qoff[0] = w * 32; qoff[1] = w * 32 + 16; }
  bf16x8 aq[2][2];
  uint2 gpre[2][4];
#pragma unroll
  for (int g = 0; g < 2; ++g) {
    const size_t rowo = (size_t)(Tq0 + qoff[g] + r16) * 4096;
    const u16* qp = p.proj + rowo + qcol + h * 64 + quad * 8;
    aq[g][0] = ld8(qp);
    aq[g][1] = ld8(qp + 32);
    const u16* gp = p.proj + rowo + gcol + h * 64 + quad * 4;
#pragma unroll
    for (int n = 0; n < 4; ++n) gpre[g][n] = *reinterpret_cast<const uint2*>(gp + n * 16);
  }
  f32x4 o[2][4];
  float m[2] = {-1e30f, -1e30f}, ls[2] = {0.f, 0.f};
#pragma unroll
  for (int g = 0; g < 2; ++g)
#pragma unroll
    for (int n = 0; n < 4; ++n) o[g][n] = (f32x4){0.f, 0.f, 0.f, 0.f};
  auto nomask = [](int, float s) { return s; };

  int nloc, loc0, ktlo = 0, R0 = 0;
  const int kcol = isA ? 256 + kv * 64 : 1024 + h * 64;
  const int vcol = isA ? 384 + kv * 64 : 1280 + h * 64;
  if (KIND < 2) { nloc = 4; loc0 = b * 256; }
  else if (KIND == 2) {
    ktlo = 2 * qt - 2; if (ktlo < 0) ktlo = 0;
    int kthi = 2 * qt + 3; if (kthi > 31) kthi = 31;
    nloc = kthi - ktlo + 1;
    loc0 = NCTX + b * 2048 + ktlo * 64;
  } else {
    const int r0 = 2 * qt;
    R0 = r0 - 4; R0 = R0 < 0 ? 0 : (R0 > 24 ? 24 : R0);
    int R1 = r0 + 1 - 4; R1 = R1 < 0 ? 0 : (R1 > 24 ? 24 : R1);
    nloc = R1 + 8 - R0;
    loc0 = NCTX + b * 2048 + R0 * 64;
  }
  const int ntot = nloc + (KIND >= 2 ? 4 : 0);
  const u16* ck = nullptr; const u16* cv = nullptr; int cstride = 0;
  if (KIND == 2) { const size_t ro = (size_t)(b * 256) * 128 + kv * 64; ck = p.cbak + ro; cv = p.cbav + ro; cstride = 128; }
  if (KIND == 3) { const size_t ro = (size_t)(b * 256) * 256 + h * 64; ck = p.cbbk + ro; cv = p.cbbv + ro; cstride = 256; }
  int kbeg[2] = {0, 0};
  int myrow = 0, myR0 = 0;
  if (KIND == 3) {
    myrow = 2 * qt + (w >> 1);
    myR0 = myrow - 4; myR0 = myR0 < 0 ? 0 : (myR0 > 24 ? 24 : myR0);
#pragma unroll
    for (int g = 0; g < 2; ++g) {
      const int cb = (w & 1) * 2 + g;
      int kb = 16 * cb - 8; kb = kb < 0 ? 0 : (kb > 32 ? 32 : kb);
      kbeg[g] = kb;
    }
    __syncthreads();
    for (int i = tid; i < 15 * 31; i += 256) rpbs[i] = p.rpb[(size_t)((l * 4 + h) * 15) * 31 + i] * LOG2E;
  }
  uint4 ak0, ak1, av0, av1, bk0, bk1, bv0, bv1;
  auto issue = [&](int vt, uint4& k0, uint4& k1, uint4& v0, uint4& v1) {
    if (vt < nloc) {
      const u16* base = p.proj + (size_t)(loc0 + vt * 64) * 4096;
      kv_issue_b(k0, k1, v0, v1, base + kcol, base + vcol, 4096, tid);
    } else {
      const size_t ro = (size_t)((vt - nloc) * 64) * cstride;
      kv_issue_b(k0, k1, v0, v1, ck + ro, cv + ro, (size_t)cstride, tid);
    }
  };
  auto do_step = [&](int vt) {
#pragma unroll
    for (int g = 0; g < 2; ++g) {
      if (vt >= nloc || KIND < 2) {
        attn_step<4>(Ksh, Vt, 0, aq[g], o[g], m[g], ls[g], nomask, r16, quad);
      } else if (KIND == 2) {
        const int kpos0 = (ktlo + vt) * 64 - qt * 128;
        const int qa = qoff[g];
        const bool skip = (qa - (kpos0 + 63) > 128) || (qa + 15 - kpos0 < -128);
        if (!skip) {
          const int qrel = qa + r16 - kpos0;
          auto mk = [qrel](int key, float s) {
            int d = qrel - key;
            return (d <= 128 && d >= -128) ? s : -1e30f;
          };
          attn_step<4>(Ksh, Vt, 0, aq[g], o[g], m[g], ls[g], mk, r16, quad);
        }
      } else {
        const int kr = R0 + vt;
        if (kr >= myR0 && kr < myR0 + 8) {
          const int qc = ((w & 1) * 2 + g) * 16 + r16;
          int qws = qc - 8; qws = qws < 0 ? 0 : (qws > 48 ? 48 : qws);
          const float* rbp = rpbs + (kr - myrow + 7) * 31 + 15 - qc;
          auto mk = [qws, rbp](int key, float s) {
            bool ok = (key >= qws) && (key < qws + 16);
            return ok ? (s + rbp[ok ? key : qws]) : -1e30f;
          };
          attn_step<2>(Ksh, Vt, kbeg[g], aq[g], o[g], m[g], ls[g], mk, r16, quad);
        }
      }
    }
  };
  issue(0, ak0, ak1, av0, av1);
  if (ntot > 1) issue(1, bk0, bk1, bv0, bv1);
#pragma unroll 1
  for (int vt = 0; vt < ntot; vt += 2) {
    __syncthreads();
    kv_commit_b(ak0, ak1, av0, av1, Ksh, Vt, tid);
    __syncthreads();
    if (vt + 2 < ntot) issue(vt + 2, ak0, ak1, av0, av1);
    do_step(vt);
    if (vt + 1 < ntot) {
      __syncthreads();
      kv_commit_b(bk0, bk1, bv0, bv1, Ksh, Vt, tid);
      __syncthreads();
      if (vt + 3 < ntot) issue(vt + 3, bk0, bk1, bv0, bv1);
      do_step(vt + 1);
    }
  }
#pragma unroll
  for (int g = 0; g < 2; ++g) {
    float tot = ls[g] + __shfl_xor(ls[g], 16);
    tot += __shfl_xor(tot, 32);
    float sc = 1.f;
    if (isA) {
      const float sk = p.sink[l * 4 + h] * LOG2E;
      const float mn = fmaxf(m[g], sk);
      const float al = fexp2(m[g] - mn);
      tot = tot * al + fexp2(sk - mn);
      sc = al;
    }
    const float inv = sc / tot;
    const int T = Tq0 + qoff[g] + r16;
#pragma unroll
    for (int n = 0; n < 4; ++n) {
      const int dv = n * 16 + quad * 4;
      const uint2 gg = gpre[g][n];
      uint2 ov;
      ov.x = pack2(o[g][n][0] * inv * silu_f(bflo(gg.x)), o[g][n][1] * inv * silu_f(bfhi(gg.x)));
      ov.y = pack2(o[g][n][2] * inv * silu_f(bflo(gg.y)), o[g][n][3] * inv * silu_f(bfhi(gg.y)));
      *reinterpret_cast<uint2*>(p.hbuf + (size_t)T * HS + mixcol + h * 64 + dv) = ov;
    }
  }
  __syncthreads();
}

__device__ void csum_item(const Params& p, int l, int it, unsigned char* smem) {
  u16* Ktf = (u16*)smem;
  u16* Ktb = Ktf + 64 * 72;
  u16* Vt = Ktb + 64 * 72;
  const int tid = otid(), w = tid >> 6, lane = tid & 63, r16 = lane & 15, quad = lane >> 4;
  const int c = it >> 2, h = it & 3, T0 = c * 64;
  const float lgf = ret_lg2(p, l, 0, h), lgb = ret_lg2(p, l, 1, h);
  __syncthreads();
  {
    const int dc = tid >> 5, kp = tid & 31, j0 = 2 * kp, j1 = j0 + 1;
    const u16* kb = p.proj + (size_t)(T0 + j0) * 4096 + 2048 + h * 64 + dc * 8;
    uint4 a = *reinterpret_cast<const uint4*>(kb);
    uint4 b = *reinterpret_cast<const uint4*>(kb + 4096);
    unsigned av[4] = {a.x, a.y, a.z, a.w}, bv[4] = {b.x, b.y, b.z, b.w};
    const float wf0 = 0.125f * fexp2(lgf * (float)(63 - j0)), wf1 = 0.125f * fexp2(lgf * (float)(63 - j1));
    const float wb0 = 0.125f * fexp2(lgb * (float)j0), wb1 = 0.125f * fexp2(lgb * (float)j1);
#pragma unroll
    for (int i = 0; i < 4; ++i) {
      float k0l = bflo(av[i]), k0h = bfhi(av[i]), k1l = bflo(bv[i]), k1h = bfhi(bv[i]);
      *reinterpret_cast<unsigned*>(Ktf + (dc * 8 + 2 * i) * 72 + j0) = pack2(k0l * wf0, k1l * wf1);
      *reinterpret_cast<unsigned*>(Ktf + (dc * 8 + 2 * i + 1) * 72 + j0) = pack2(k0h * wf0, k1h * wf1);
      *reinterpret_cast<unsigned*>(Ktb + (dc * 8 + 2 * i) * 72 + j0) = pack2(k0l * wb0, k1l * wb1);
      *reinterpret_cast<unsigned*>(Ktb + (dc * 8 + 2 * i + 1) * 72 + j0) = pack2(k0h * wb0, k1h * wb1);
    }
  }
  ld_tr_bf16(Vt, p.proj + (size_t)T0 * 4096 + 2304 + h * 64, 4096);
  __syncthreads();
#pragma unroll
  for (int dir = 0; dir < 2; ++dir) {
    const u16* Kt = dir ? Ktb : Ktf;
    f32x4 acc[4];
#pragma unroll
    for (int mt = 0; mt < 4; ++mt) acc[mt] = (f32x4){0.f, 0.f, 0.f, 0.f};
#pragma unroll
    for (int ks = 0; ks < 2; ++ks) {
      bf16x8 bv = ld8(Vt + (w * 16 + r16) * 72 + ks * 32 + quad * 8);
#pragma unroll
      for (int mt = 0; mt < 4; ++mt) acc[mt] = mfma16(ld8(Kt + (mt * 16 + r16) * 72 + ks * 32 + quad * 8), bv, acc[mt]);
    }
    u16* U = p.uc + (size_t)((c * 4 + h) * 2 + dir) * 4096 + (w * 16 + r16) * 64;
#pragma unroll
    for (int mt = 0; mt < 4; ++mt) {
      uint2 o;
      o.x = pack2(acc[mt][0], acc[mt][1]);
      o.y = pack2(acc[mt][2], acc[mt][3]);
      *reinterpret_cast<uint2*>(U + mt * 16 + quad * 4) = o;
    }
  }
  __syncthreads();
}

__device__ __forceinline__ void hgrn_gates(const uint4 a, const uint4 b, int dir, const float* lbs, float* Bc, float* kkf, u16* kkb, float* segtot) {
  const int tid = otid();
  {
    const int j = tid >> 2, part = (tid & 3) * 16;
    unsigned zz[8] = {a.x, a.y, a.z, a.w, b.x, b.y, b.z, b.w};
    float lfv[16], kfv[16];
#pragma unroll
    for (int i = 0; i < 16; ++i) {
      float z = (i & 1) ? bfhi(zz[i >> 1]) : bflo(zz[i >> 1]);
      float lb = fmaxf(lbs[dir * 64 + part + i], 1e-30f);
      float sneg = __builtin_amdgcn_rcpf(1.f + __expf(z));
      float spos = __builtin_amdgcn_rcpf(1.f + __expf(-z));
      kfv[i] = (1.f - lb) * sneg;
      float f = lb + (1.f - lb) * spos;
      lfv[i] = __log2f(fmaxf(f, 1e-30f));
    }
#pragma unroll
    for (int i = 0; i < 4; ++i) {
      *reinterpret_cast<float4*>(Bc + j * 68 + part + 4 * i) = make_float4(lfv[4 * i], lfv[4 * i + 1], lfv[4 * i + 2], lfv[4 * i + 3]);
      if (kkf) *reinterpret_cast<float4*>(kkf + j * 68 + part + 4 * i) = make_float4(kfv[4 * i], kfv[4 * i + 1], kfv[4 * i + 2], kfv[4 * i + 3]);
    }
    if (kkb) {
      uint4 o0, o1;
      o0.x = pack2(kfv[0], kfv[1]); o0.y = pack2(kfv[2], kfv[3]); o0.z = pack2(kfv[4], kfv[5]); o0.w = pack2(kfv[6], kfv[7]);
      o1.x = pack2(kfv[8], kfv[9]); o1.y = pack2(kfv[10], kfv[11]); o1.z = pack2(kfv[12], kfv[13]); o1.w = pack2(kfv[14], kfv[15]);
      *reinterpret_cast<uint4*>(kkb + j * 72 + part) = o0;
      *reinterpret_cast<uint4*>(kkb + j * 72 + part + 8) = o1;
    }
  }
  __syncthreads();
  const int ch = tid & 63, seg = tid >> 6;
  float v[16];
#pragma unroll
  for (int jj = 0; jj < 16; ++jj) v[jj] = Bc[(seg * 16 + jj) * 68 + ch];
  float tot;
  if (dir == 0) {
#pragma unroll
    for (int jj = 1; jj < 16; ++jj) v[jj] += v[jj - 1];
    tot = v[15];
  } else {
#pragma unroll
    for (int jj = 14; jj >= 0; --jj) v[jj] += v[jj + 1];
    tot = v[0];
  }
  segtot[seg * 64 + ch] = tot;
  __syncthreads();
  float off = 0.f;
#pragma unroll
  for (int s2 = 0; s2 < 4; ++s2) {
    const float t2 = segtot[s2 * 64 + ch];
    const bool use = dir ? (s2 > seg) : (s2 < seg);
    off += use ? t2 : 0.f;
  }
#pragma unroll
  for (int jj = 0; jj < 16; ++jj) Bc[(seg * 16 + jj) * 68 + ch] = v[jj] + off;
  __syncthreads();
}

__device__ void dsum_item(const Params& p, int l, int it, unsigned char* smem) {
  float* Bc = (float*)smem;
  float* kk = Bc + 64 * 68;
  u16* Kt = (u16*)(kk + 64 * 68);
  u16* Vt = Kt + 64 * 72;
  float* lbs = (float*)(Vt + 64 * 72);
  const int tid = otid(), w = tid >> 6, lane = tid & 63, r16 = lane & 15, quad = lane >> 4;
  const int c = it >> 2, h = it & 3, T0 = c * 64;
  __syncthreads();
  uint4 zf0, zf1, zb0, zb1;
  {
    const u16* zp = p.proj + (size_t)(T0 + (tid >> 2)) * 4096 + 3072 + h * 64 + (tid & 3) * 16;
    zf0 = *reinterpret_cast<const uint4*>(zp); zf1 = *reinterpret_cast<const uint4*>(zp + 8);
    zb0 = *reinterpret_cast<const uint4*>(zp + 256); zb1 = *reinterpret_cast<const uint4*>(zp + 264);
  }
  if (tid < 128) lbs[tid] = hgrn_lb(p, l, tid >> 6, h * 64 + (tid & 63));
  ld_tr_bf16(Vt, p.proj + (size_t)T0 * 4096 + 3584 + h * 64, 4096);
  __syncthreads();
#pragma unroll
  for (int dir = 0; dir < 2; ++dir) {
    hgrn_gates(dir ? zb0 : zf0, dir ? zb1 : zf1, dir, lbs, Bc, kk, nullptr, lbs + 128);
    const int lastj = dir ? 0 : 63;
    {
      const int j = tid >> 2, part = (tid & 3) * 16;
#pragma unroll
      for (int i4 = 0; i4 < 4; ++i4) {
        const int ch = part + 4 * i4;
        float4 kv4 = *reinterpret_cast<const float4*>(kk + j * 68 + ch);
        float4 bl = *reinterpret_cast<const float4*>(Bc + lastj * 68 + ch);
        float4 bj = *reinterpret_cast<const float4*>(Bc + j * 68 + ch);
        Kt[(ch + 0) * 72 + j] = f2bf(kv4.x * fexp2(bl.x - bj.x));
        Kt[(ch + 1) * 72 + j] = f2bf(kv4.y * fexp2(bl.y - bj.y));
        Kt[(ch + 2) * 72 + j] = f2bf(kv4.z * fexp2(bl.z - bj.z));
        Kt[(ch + 3) * 72 + j] = f2bf(kv4.w * fexp2(bl.w - bj.w));
      }
    }
    if (tid < 64) p.dg[(size_t)((c * 4 + h) * 2 + dir) * 64 + tid] = fexp2(Bc[lastj * 68 + tid]);
    __syncthreads();
    f32x4 acc[4];
#pragma unroll
    for (int mt = 0; mt < 4; ++mt) acc[mt] = (f32x4){0.f, 0.f, 0.f, 0.f};
#pragma unroll
    for (int ks = 0; ks < 2; ++ks) {
      bf16x8 bv = ld8(Vt + (w * 16 + r16) * 72 + ks * 32 + quad * 8);
#pragma unroll
      for (int mt = 0; mt < 4; ++mt) acc[mt] = mfma16(ld8(Kt + (mt * 16 + r16) * 72 + ks * 32 + quad * 8), bv, acc[mt]);
    }
    u16* U = p.ud + (size_t)((c * 4 + h) * 2 + dir) * 4096 + (w * 16 + r16) * 64;
#pragma unroll
    for (int mt = 0; mt < 4; ++mt) {
      uint2 o;
      o.x = pack2(acc[mt][0], acc[mt][1]);
      o.y = pack2(acc[mt][2], acc[mt][3]);
      *reinterpret_cast<uint2*>(U + mt * 16 + quad * 4) = o;
    }
    __syncthreads();
  }
}

template <int ISD, int NB>
__device__ __forceinline__ void scan_batch(u16* U, const float* dgp, int c0, int cstep, int h, int dir, int e, int dk, float dec,
                                           float& S0, float& S1, float& S2, float& S3) {
  unsigned u[NB], w2[NB];
  float2 d[NB];
#pragma unroll
  for (int i = 0; i < NB; ++i) {
    const int c = c0 + i * cstep;
    const size_t blk = (size_t)((c * 4 + h) * 2 + dir);
    u[i] = *reinterpret_cast<const unsigned*>(U + blk * 4096 + e);
    w2[i] = *reinterpret_cast<const unsigned*>(U + blk * 4096 + e + 2048);
    if (ISD) d[i] = *reinterpret_cast<const float2*>(dgp + blk * 64 + dk);
  }
#pragma unroll
  for (int i = 0; i < NB; ++i) {
    const int c = c0 + i * cstep;
    const size_t blk = (size_t)((c * 4 + h) * 2 + dir);
    *reinterpret_cast<unsigned*>(U + blk * 4096 + e) = pack2(S0, S1);
    *reinterpret_cast<unsigned*>(U + blk * 4096 + e + 2048) = pack2(S2, S3);
    const float d0 = ISD ? d[i].x : dec, d1 = ISD ? d[i].y : dec;
    S0 = S0 * d0 + bflo(u[i]);
    S1 = S1 * d1 + bfhi(u[i]);
    S2 = S2 * d0 + bflo(w2[i]);
    S3 = S3 * d1 + bfhi(w2[i]);
  }
}
template <int ISD>
__device__ void scan_item(const Params& p, int l, int it) {
  const int tid = otid();
  const int part = it & 3, dir = (it >> 2) & 1, h = (it >> 3) & 3, sidx = it >> 5;
  const int e = (part * 256 + tid) * 2, dv = e >> 6, dk = e & 63;
  const bool ctx = sidx < 16;
  const int nch = ctx ? 4 : 32;
  const int cb = ctx ? sidx * 4 : 64 + (sidx - 16) * 32;
  u16* U = ISD ? p.ud : p.uc;
  float dec = 0.f;
  if (!ISD) dec = fexp2(64.f * ret_lg2(p, l, dir, h));
  float S0 = 0.f, S1 = 0.f, S2 = 0.f, S3 = 0.f;
  if (!ctx) {
    const float* st = (ISD ? p.st_hgrn : p.st_ret) + (size_t)((((sidx - 16) * 4 + l) * 2 + dir) * 4 + h) * 4096;
    S0 = st[dk * 64 + dv];
    S1 = st[(dk + 1) * 64 + dv];
    S2 = st[dk * 64 + dv + 32];
    S3 = st[(dk + 1) * 64 + dv + 32];
  }
  const int cstart = dir ? (cb + nch - 1) : cb, cstep = dir ? -1 : 1;
  if (ctx) {
    scan_batch<ISD, 4>(U, p.dg, cstart, cstep, h, dir, e, dk, dec, S0, S1, S2, S3);
    float* os = p.out + (ISD ? OUT_SH : OUT_SR) + (size_t)(((sidx * 4 + l) * 2 + dir) * 4 + h) * 4096;
    os[dk * 64 + dv] = S0;
    os[(dk + 1) * 64 + dv] = S1;
    os[dk * 64 + dv + 32] = S2;
    os[(dk + 1) * 64 + dv + 32] = S3;
  } else {
    scan_batch<ISD, 16>(U, p.dg, cstart, cstep, h, dir, e, dk, dec, S0, S1, S2, S3);
    scan_batch<ISD, 16>(U, p.dg, cstart + 16 * cstep, cstep, h, dir, e, dk, dec, S0, S1, S2, S3);
  }
}

__device__ __forceinline__ void load_gate_rows(const Params& p, int Trow0, int gcol, int lane, uint4& g0, uint4& g1) {
  const int row = lane >> 2, c0 = (lane & 3) * 16;
  const u16* gp = p.proj + (size_t)(Trow0 + row) * 4096 + gcol + c0;
  g0 = *reinterpret_cast<const uint4*>(gp);
  g1 = *reinterpret_cast<const uint4*>(gp + 8);
}
__device__ __forceinline__ void store_rows_gated(const Params& p, float* stg  , const float (&val)[4][4],
                                                 int Trow0, const uint4 g0, const uint4 g1, int mcol, int lane) {
  const int r16 = lane & 15, quad = lane >> 4;
#pragma unroll
  for (int n = 0; n < 4; ++n)
#pragma unroll
    for (int j = 0; j < 4; ++j) stg[(quad * 4 + j) * 68 + n * 16 + r16] = val[n][j];
  wave_lds_sync();
  const int row = lane >> 2, c0 = (lane & 3) * 16;
  const int T = Trow0 + row;
  unsigned gw[8] = {g0.x, g0.y, g0.z, g0.w, g1.x, g1.y, g1.z, g1.w};
  unsigned ow[8];
#pragma unroll
  for (int i = 0; i < 4; ++i) {
    float4 v = *reinterpret_cast<const float4*>(stg + row * 68 + c0 + 4 * i);
    ow[2 * i] = pack2(v.x * silu_f(bflo(gw[2 * i])), v.y * silu_f(bfhi(gw[2 * i])));
    ow[2 * i + 1] = pack2(v.z * silu_f(bflo(gw[2 * i + 1])), v.w * silu_f(bfhi(gw[2 * i + 1])));
  }
  u16* op = p.hbuf + (size_t)T * HS + mcol + c0;
  *reinterpret_cast<uint4*>(op) = make_uint4(ow[0], ow[1], ow[2], ow[3]);
  *reinterpret_cast<uint4*>(op + 8) = make_uint4(ow[4], ow[5], ow[6], ow[7]);
}

__device__ void cout_item(const Params& p, int l, int it, unsigned char* smem) {
  u16* Qs = (u16*)smem;
  u16* Ks = Qs + 64 * 72;
  u16* Vt = Ks + 64 * 72;
  u16* SfT = Vt + 64 * 72;
  u16* SbT = SfT + 64 * 72;
  u16* Ps = SbT + 64 * 72;
  const int tid = otid(), w = tid >> 6, lane = tid & 63, r16 = lane & 15, quad = lane >> 4;
  const int c = it >> 2, h = it & 3, T0 = c * 64;
  const float lgf = ret_lg2(p, l, 0, h), lgb = ret_lg2(p, l, 1, h);
  uint4 gt0, gt1;
  load_gate_rows(p, T0 + w * 16, 2560 + h * 64, lane, gt0, gt1);
  __syncthreads();
  const u16* base = p.proj + (size_t)T0 * 4096;
  ld_rows_bf16(Qs, base + 1792 + h * 64, 4096);
  ld_rows_bf16(Ks, base + 2048 + h * 64, 4096);
  ld_tr_bf16(Vt, base + 2304 + h * 64, 4096);
  ld_rows_bf16(SfT, p.uc + (size_t)((c * 4 + h) * 2 + 0) * 4096, 64);
  ld_rows_bf16(SbT, p.uc + (size_t)((c * 4 + h) * 2 + 1) * 4096, 64);
  __syncthreads();
  const int i0 = w * 16;
  bf16x8 aq[2];
  aq[0] = ld8(Qs + (i0 + r16) * 72 + quad * 8);
  aq[1] = ld8(Qs + (i0 + r16) * 72 + 32 + quad * 8);
  f32x4 s[4];
#pragma unroll
  for (int nt = 0; nt < 4; ++nt) {
    s[nt] = (f32x4){0.f, 0.f, 0.f, 0.f};
#pragma unroll
    for (int ks = 0; ks < 2; ++ks) s[nt] = mfma16(aq[ks], ld8(Ks + (nt * 16 + r16) * 72 + ks * 32 + quad * 8), s[nt]);
  }
#pragma unroll
  for (int nt = 0; nt < 4; ++nt)
#pragma unroll
    for (int j = 0; j < 4; ++j) {
      const int i = i0 + quad * 4 + j, jj = nt * 16 + r16, d = i - jj;
      float wgt = (d > 0) ? fexp2(lgf * (float)d) : ((d < 0) ? fexp2(lgb * (float)(-d)) : 2.f);
      Ps[i * 72 + jj] = f2bf(s[nt][j] * 0.125f * wgt);
    }
  wave_lds_sync();
  f32x4 o[4], xf[4], xb[4];
#pragma unroll
  for (int n = 0; n < 4; ++n) { o[n] = (f32x4){0.f, 0.f, 0.f, 0.f}; xf[n] = o[n]; xb[n] = o[n]; }
#pragma unroll
  for (int ks = 0; ks < 2; ++ks) {
    bf16x8 ap = ld8(Ps + (i0 + r16) * 72 + ks * 32 + quad * 8);
#pragma unroll
    for (int n = 0; n < 4; ++n) {
      o[n] = mfma16(ap, ld8(Vt + (n * 16 + r16) * 72 + ks * 32 + quad * 8), o[n]);
      xf[n] = mfma16(aq[ks], ld8(SfT + (n * 16 + r16) * 72 + ks * 32 + quad * 8), xf[n]);
      xb[n] = mfma16(aq[ks], ld8(SbT + (n * 16 + r16) * 72 + ks * 32 + quad * 8), xb[n]);
    }
  }
  float val[4][4];
#pragma unroll
  for (int j = 0; j < 4; ++j) {
    const int i = i0 + quad * 4 + j;
    const float qf = fexp2(lgf * (float)(i + 1)), qb = fexp2(lgb * (float)(64 - i));
    float t[4], sum = 0.f;
#pragma unroll
    for (int n = 0; n < 4; ++n) { t[n] = o[n][j] + qf * xf[n][j] + qb * xb[n][j]; sum += t[n]; }
    const float mu = gsum16(sum) * (1.f / 64.f);
    float vs = 0.f;
#pragma unroll
    for (int n = 0; n < 4; ++n) { t[n] -= mu; vs += t[n] * t[n]; }
    const float rstd = rsqrtf(gsum16(vs) * (1.f / 64.f) + 1e-6f);
#pragma unroll
    for (int n = 0; n < 4; ++n) val[n][j] = t[n] * rstd;
  }
  __syncthreads();
  store_rows_gated(p, (float*)smem + w * (16 * 68), val, T0 + i0, gt0, gt1, 512 + h * 64, lane);
  __syncthreads();
}

__device__ void dout_item(const Params& p, int l, int it, unsigned char* smem) {
  u16* qs = (u16*)smem;
  u16* Vt = qs + 64 * 72;
  u16* kkb = Vt + 64 * 72;
  u16* Kt = kkb + 64 * 72;
  u16* ST = Kt + 64 * 72;
  u16* Ps = ST + 64 * 72;
  float* Bc = (float*)(Ps + 64 * 72);
  float* Rref = Bc + 64 * 68;
  float* lbs = Rref + 256;
  const int tid = otid(), w = tid >> 6, lane = tid & 63, r16 = lane & 15, quad = lane >> 4;
  const int c = it >> 2, h = it & 3, T0 = c * 64;
  uint4 gt0, gt1;
  load_gate_rows(p, T0 + w * 16, 3840 + h * 64, lane, gt0, gt1);
  uint4 zf0, zf1, zb0, zb1, sf0, sf1, sb0, sb1;
  {
    const int row = tid >> 2, part = (tid & 3) * 16;
    const u16* zp = p.proj + (size_t)(T0 + row) * 4096 + 3072 + h * 64 + part;
    zf0 = *reinterpret_cast<const uint4*>(zp); zf1 = *reinterpret_cast<const uint4*>(zp + 8);
    zb0 = *reinterpret_cast<const uint4*>(zp + 256); zb1 = *reinterpret_cast<const uint4*>(zp + 264);
    const u16* sp = p.ud + (size_t)((c * 4 + h) * 2) * 4096 + row * 64 + part;
    sf0 = *reinterpret_cast<const uint4*>(sp); sf1 = *reinterpret_cast<const uint4*>(sp + 8);
    sb0 = *reinterpret_cast<const uint4*>(sp + 4096); sb1 = *reinterpret_cast<const uint4*>(sp + 4096 + 8);
  }
  __syncthreads();
  if (tid < 128) lbs[tid] = hgrn_lb(p, l, tid >> 6, h * 64 + (tid & 63));
  {
    const int row = tid >> 2, part = (tid & 3) * 16;
    const u16* s = p.proj + (size_t)(T0 + row) * 4096 + 2816 + h * 64 + part;
    uint4 a = *reinterpret_cast<const uint4*>(s), b = *reinterpret_cast<const uint4*>(s + 8);
    unsigned zz[8] = {a.x, a.y, a.z, a.w, b.x, b.y, b.z, b.w};
#pragma unroll
    for (int i = 0; i < 8; ++i) zz[i] = pack2(silu_f(bflo(zz[i])), silu_f(bfhi(zz[i])));
    uint4 o0 = {zz[0], zz[1], zz[2], zz[3]}, o1 = {zz[4], zz[5], zz[6], zz[7]};
    *reinterpret_cast<uint4*>(qs + row * 72 + part) = o0;
    *reinterpret_cast<uint4*>(qs + row * 72 + part + 8) = o1;
  }
  ld_tr_bf16(Vt, p.proj + (size_t)T0 * 4096 + 3584 + h * 64, 4096);
  f32x4 o[4];
#pragma unroll
  for (int n = 0; n < 4; ++n) o[n] = (f32x4){0.f, 0.f, 0.f, 0.f};
  const int I = w;
#pragma unroll
  for (int dir = 0; dir < 2; ++dir) {
    __syncthreads();
    {
      const int row = tid >> 2, part = (tid & 3) * 16;
      *reinterpret_cast<uint4*>(ST + row * 72 + part) = dir ? sb0 : sf0;
      *reinterpret_cast<uint4*>(ST + row * 72 + part + 8) = dir ? sb1 : sf1;
    }
    hgrn_gates(dir ? zb0 : zf0, dir ? zb1 : zf1, dir, lbs, Bc, nullptr, kkb, Rref);
    Rref[tid] = Bc[((tid >> 6) * 16 + (dir ? 0 : 15)) * 68 + (tid & 63)];
    __syncthreads();
    {
      const int j = tid >> 2, part = (tid & 3) * 16;
      unsigned ov[8];
      uint4 kk0 = *reinterpret_cast<const uint4*>(kkb + j * 72 + part), kk1 = *reinterpret_cast<const uint4*>(kkb + j * 72 + part + 8);
      unsigned kw[8] = {kk0.x, kk0.y, kk0.z, kk0.w, kk1.x, kk1.y, kk1.z, kk1.w};
#pragma unroll
      for (int i4 = 0; i4 < 4; ++i4) {
        float4 rr = *reinterpret_cast<const float4*>(Rref + (j >> 4) * 64 + part + 4 * i4);
        float4 bb = *reinterpret_cast<const float4*>(Bc + j * 68 + part + 4 * i4);
        ov[2 * i4] = pack2(bflo(kw[2 * i4]) * fexp2(rr.x - bb.x), bfhi(kw[2 * i4]) * fexp2(rr.y - bb.y));
        ov[2 * i4 + 1] = pack2(bflo(kw[2 * i4 + 1]) * fexp2(rr.z - bb.z), bfhi(kw[2 * i4 + 1]) * fexp2(rr.w - bb.w));
      }
      uint4 o0 = {ov[0], ov[1], ov[2], ov[3]}, o1 = {ov[4], ov[5], ov[6], ov[7]};
      *reinterpret_cast<uint4*>(Kt + j * 72 + part) = o0;
      *reinterpret_cast<uint4*>(Kt + j * 72 + part + 8) = o1;
    }
    __syncthreads();
    f32x4 sacc[4];
#pragma unroll
    for (int J = 0; J < 4; ++J) sacc[J] = (f32x4){0.f, 0.f, 0.f, 0.f};
    const int irow = 16 * I + r16;
#pragma unroll
    for (int J = 0; J < 4; ++J) {
      const bool act = dir ? (J > I) : (J < I);
      if (act) {
#pragma unroll
        for (int ks = 0; ks < 2; ++ks) {
          const int ch0 = ks * 32 + quad * 8;
          uint4 qv = *reinterpret_cast<const uint4*>(qs + irow * 72 + ch0);
          unsigned qq[4] = {qv.x, qv.y, qv.z, qv.w};
          float4 b0 = *reinterpret_cast<const float4*>(Bc + irow * 68 + ch0), b1 = *reinterpret_cast<const float4*>(Bc + irow * 68 + ch0 + 4);
          float4 r0 = *reinterpret_cast<const float4*>(Rref + J * 64 + ch0), r1 = *reinterpret_cast<const float4*>(Rref + J * 64 + ch0 + 4);
          union { unsigned u[4]; bf16x8 v; } a;
          a.u[0] = pack2(bflo(qq[0]) * fexp2(b0.x - r0.x), bfhi(qq[0]) * fexp2(b0.y - r0.y));
          a.u[1] = pack2(bflo(qq[1]) * fexp2(b0.z - r0.z), bfhi(qq[1]) * fexp2(b0.w - r0.w));
          a.u[2] = pack2(bflo(qq[2]) * fexp2(b1.x - r1.x), bfhi(qq[2]) * fexp2(b1.y - r1.y));
          a.u[3] = pack2(bflo(qq[3]) * fexp2(b1.z - r1.z), bfhi(qq[3]) * fexp2(b1.w - r1.w));
          sacc[J] = mfma16(a.v, ld8(Kt + (16 * J + r16) * 72 + ch0), sacc[J]);
        }
      }
    }
#pragma unroll
    for (int J = 0; J < 4; ++J)
#pragma unroll
      for (int j = 0; j < 4; ++j) Ps[(16 * I + quad * 4 + j) * 72 + 16 * J + r16] = f2bf(sacc[J][j]);
    {
      const int rbase = 16 * I;
#pragma unroll 3
      for (int itq = 0; itq < 9; ++itq) {
        const int qp = itq * 64 + lane;
        const bool valid = qp < 544;
        const int pp = valid ? (qp >> 2) : 0, cq = qp & 3;
        int a2 = (int)((sqrtf(8.f * (float)pp + 1.f) - 1.f) * 0.5f);
        if ((a2 + 1) * (a2 + 2) / 2 <= pp) ++a2;
        if (a2 * (a2 + 1) / 2 > pp) --a2;
        const int b2 = pp - a2 * (a2 + 1) / 2;
        const int i = rbase + (dir ? b2 : a2), key = rbase + (dir ? a2 : b2);
        float sum = 0.f;
#pragma unroll
        for (int c8 = 0; c8 < 2; ++c8) {
          const int ch0 = cq * 16 + c8 * 8;
          uint4 kq = *reinterpret_cast<const uint4*>(kkb + key * 72 + ch0);
          unsigned kq4[4] = {kq.x, kq.y, kq.z, kq.w};
          float4 bk0 = *reinterpret_cast<const float4*>(Bc + key * 68 + ch0);
          float4 bk1 = *reinterpret_cast<const float4*>(Bc + key * 68 + ch0 + 4);
          float bk[8] = {bk0.x, bk0.y, bk0.z, bk0.w, bk1.x, bk1.y, bk1.z, bk1.w};
          uint4 qv = *reinterpret_cast<const uint4*>(qs + i * 72 + ch0);
          unsigned qq[4] = {qv.x, qv.y, qv.z, qv.w};
          float4 bi0 = *reinterpret_cast<const float4*>(Bc + i * 68 + ch0);
          float4 bi1 = *reinterpret_cast<const float4*>(Bc + i * 68 + ch0 + 4);
          float bi[8] = {bi0.x, bi0.y, bi0.z, bi0.w, bi1.x, bi1.y, bi1.z, bi1.w};
#pragma unroll
          for (int e2 = 0; e2 < 4; ++e2) {
            float w0 = fexp2(fminf(bi[2 * e2] - bk[2 * e2], 0.f));
            float w1 = fexp2(fminf(bi[2 * e2 + 1] - bk[2 * e2 + 1], 0.f));
            sum += bflo(qq[e2]) * bflo(kq4[e2]) * w0 + bfhi(qq[e2]) * bfhi(kq4[e2]) * w1;
          }
        }
        sum += DPPF(sum, 0xB1);
        sum += DPPF(sum, 0x4E);
        if (valid && cq == 0) Ps[i * 72 + key] = f2bf(sum);
      }
    }
    wave_lds_sync();
#pragma unroll
    for (int ks = 0; ks < 2; ++ks) {
      const int ch0 = ks * 32 + quad * 8;
      bf16x8 ap = ld8(Ps + irow * 72 + ch0);
      uint4 qv = *reinterpret_cast<const uint4*>(qs + irow * 72 + ch0);
      unsigned qq[4] = {qv.x, qv.y, qv.z, qv.w};
      float4 b0 = *reinterpret_cast<const float4*>(Bc + irow * 68 + ch0), b1 = *reinterpret_cast<const float4*>(Bc + irow * 68 + ch0 + 4);
      union { unsigned u[4]; bf16x8 v; } a;
      a.u[0] = pack2(bflo(qq[0]) * fexp2(b0.x), bfhi(qq[0]) * fexp2(b0.y));
      a.u[1] = pack2(bflo(qq[1]) * fexp2(b0.z), bfhi(qq[1]) * fexp2(b0.w));
      a.u[2] = pack2(bflo(qq[2]) * fexp2(b1.x), bfhi(qq[2]) * fexp2(b1.y));
      a.u[3] = pack2(bflo(qq[3]) * fexp2(b1.z), bfhi(qq[3]) * fexp2(b1.w));
#pragma unroll
      for (int n = 0; n < 4; ++n) {
        o[n] = mfma16(ap, ld8(Vt + (n * 16 + r16) * 72 + ch0), o[n]);
        o[n] = mfma16(a.v, ld8(ST + (n * 16 + r16) * 72 + ch0), o[n]);
      }
    }
  }
  float val[4][4];
#pragma unroll
  for (int j = 0; j < 4; ++j) {
    float ss = 0.f;
#pragma unroll
    for (int n = 0; n < 4; ++n) ss += o[n][j] * o[n][j];
    const float rstd = rsqrtf(gsum16(ss) * (1.f / 64.f) + 1e-6f);
#pragma unroll
    for (int n = 0; n < 4; ++n) val[n][j] = o[n][j] * rstd;
  }
  __syncthreads();
  store_rows_gated(p, (float*)smem + w * (16 * 68), val, T0 + 16 * I, gt0, gt1, 768 + h * 64, lane);
  __syncthreads();
}

#define XB_TMO      128
#define XB_XCNT(j)  (256  + 64 * (j))
#define XB_XSUB(j)  (1280 + 64 * (j))
#define XB_XGEN(j)  (2304 + 64 * (j))
#define XB_TOP      3328
#define XB_TOPGEN   3392
#define XCD_BAR_WORDS 3456
#define XB_SPIN_CAP (1u << 18)
#define LAS __attribute__((address_space(3)))
__device__ __forceinline__ unsigned xb_ld(unsigned* p)              { return __hip_atomic_load(p, __ATOMIC_RELAXED, __HIP_MEMORY_SCOPE_AGENT); }
__device__ __forceinline__ unsigned xb_add(unsigned* p, unsigned v) { return __hip_atomic_fetch_add(p, v, __ATOMIC_RELAXED, __HIP_MEMORY_SCOPE_AGENT); }
__device__ __forceinline__ unsigned xb_xcc_id() { return (unsigned)__builtin_amdgcn_s_getreg((3 << 11) | 20) & 0xFu; }
#define XB_SPIN(cond, bar) do { unsigned _sp = 0; while (cond) { __builtin_amdgcn_s_sleep(1); \
    if ((++_sp & 255u) == 0u) { if (xb_ld(&(bar)[XB_TMO])) break; if (_sp > XB_SPIN_CAP) { atomicAdd(&(bar)[XB_TMO], 1u); break; } } } } while (0)
struct XcdBarrier { unsigned* bar; unsigned x; volatile LAS unsigned* st; };
__device__ __forceinline__ XcdBarrier xcd_barrier_post(unsigned* bar, volatile LAS unsigned* st) {
    XcdBarrier b; b.bar = bar; b.x = xb_xcc_id(); b.st = st;
    if (threadIdx.x == 0) (void)xb_add(&bar[XB_XCNT(b.x)], 1u);
    return b;
}
__device__ __forceinline__ void xcd_barrier_complete(unsigned* bar, unsigned x, unsigned& nloc, unsigned& nx) {
    const unsigned G = gridDim.x * gridDim.y * gridDim.z;
    unsigned sum, cnt, mine, sp = 0u;
    for (;;) {
        sum = 0u; cnt = 0u; mine = 0u;
#pragma unroll
        for (unsigned j = 0; j < 16; ++j) { const unsigned c = xb_ld(&bar[XB_XCNT(j)]); sum += c; cnt += (c > 0u) ? 1u : 0u; mine = (j == x) ? c : mine; }
        if (sum == G) break;
        __builtin_amdgcn_s_sleep(1);
        if ((++sp & 255u) == 0u) { if (xb_ld(&bar[XB_TMO])) break; if (sp > XB_SPIN_CAP) { atomicAdd(&bar[XB_TMO], 1u); break; } }
    }
    nloc = mine > 0u ? mine : 1u; nx = cnt > 0u ? cnt : 1u;
}
__device__ __forceinline__ void xcd_barrier(const XcdBarrier& b) {
    asm volatile("s_waitcnt vmcnt(0)" ::: "memory");
    __syncthreads();
    if (threadIdx.x == 0) {
        unsigned* bar = b.bar;
        __builtin_amdgcn_s_waitcnt(0);
        unsigned nloc = b.st[0], nx = b.st[1];
        if (nloc == 0u) { xcd_barrier_complete(bar, b.x, nloc, nx); b.st[0] = nloc; b.st[1] = nx; }
        const unsigned old = xb_add(&bar[XB_XSUB(b.x)], 1u);
        const unsigned gen = old / nloc;
        if (old + 1u == (gen + 1u) * nloc) {
            __builtin_amdgcn_fence(__ATOMIC_RELEASE, "agent");
            asm volatile("s_waitcnt vmcnt(0)" ::: "memory");
            const unsigned og = xb_add(&bar[XB_TOP], 1u);
            const unsigned tg = og / nx;
            if (og + 1u == (tg + 1u) * nx) xb_add(&bar[XB_TOPGEN], 1u);
            else XB_SPIN(xb_ld(&bar[XB_TOPGEN]) == tg, bar);
            __builtin_amdgcn_fence(__ATOMIC_ACQUIRE, "agent");
            xb_add(&bar[XB_XGEN(b.x)], 1u);
            asm volatile("s_waitcnt vmcnt(0)" ::: "memory");
        } else {
            XB_SPIN(xb_ld(&bar[XB_XGEN(b.x)]) == gen, bar);
            __builtin_amdgcn_fence(__ATOMIC_ACQUIRE, "agent");
            asm volatile("s_waitcnt vmcnt(0)" ::: "memory");
        }
    }
    __syncthreads();
}

__global__ void __launch_bounds__(256, 2) mega(Params p) {
  extern __shared__ __attribute__((aligned(16))) unsigned char smem[];
  const int nb = gridDim.x, bid = blockIdx.x;
  volatile LAS unsigned* xst = (volatile LAS unsigned*)(smem + LDS_BYTES - 16);
  if (threadIdx.x == 0) { xst[0] = 0u; xst[1] = 0u; xst[2] = 0u; xst[3] = 0u; }
  __syncthreads();
  XcdBarrier xb = xcd_barrier_post(p.bar, xst);
#pragma unroll 1
  for (int it = bid; it < 192 + 256 + 1024 + 256; it += nb) {
    if (it < 192) adaln_item(p, it, smem);
    else if (it < 448) rope_item(p, it - 192);
    else if (it < 1472) conv_tile(p.w_in, 4096, p.wt_in, it - 448, smem);
    else conv_tile(p.w_out, 1024, p.wt_out, it - 1472, smem);
  }
  xcd_barrier(xb);
#pragma unroll 1
  for (int l = 0; l < 4; ++l) {
#pragma unroll 1
    for (int rep = 0; rep < REP_P1 - 1; ++rep) prep_phase<1>(p, l, bid, nb);
    prep_phase<0>(p, l, bid, nb);
    {
      const int n = 768 + (l > 0 ? 256 : 0);
#pragma unroll 1
      for (int it = bid; it < n; it += nb) {
        if (it < 768) cache_conv_item(p, l, it);
        else conv_tile(p.w_out + (size_t)l * 1024 * 1024, 1024, p.wt_out, it - 768, smem);
      }
    }
    xcd_barrier(xb);
#pragma unroll 1
    for (int rep = 0; rep < REP_P2; ++rep)
#pragma unroll 1
    for (int it = bid; it < 2560; it += nb) gemm_big(p, l, it, smem);
    xcd_barrier(xb);
    for (int e = 0; e < EXTRA_SYNC; ++e) xcd_barrier(xb);
    {
      const int n = 128 + 128 + 1280 + 1280 + (l < 3 ? 1024 : 0);
#pragma unroll 1
      for (int rep = 0; rep < REP_P3A; ++rep)
#pragma unroll 1
      for (int it = bid; it < n; it += nb) {
        if (it < 128) attn_item<0>(p, l, it, smem);
        else if (it < 256) attn_item<1>(p, l, it - 128, smem);
        else if (it < 1536) dsum_item(p, l, it - 256, smem);
        else if (it < 2816) csum_item(p, l, it - 1536, smem);
        else conv_tile(p.w_in + (size_t)(l + 1) * 1024 * 4096, 4096, p.wt_in, it - 2816, smem);
      }
    }
    xcd_barrier(xb);
    {
      const int n = 512 + 512 + 768 + 768;
#pragma unroll 1
      for (int rep = 0; rep < REP_P3B - 1; ++rep)
#pragma unroll 1
      for (int it = bid; it < 1024; it += nb) {
        if (it < 512) attn_item<2>(p, l, it, smem);
        else attn_item<3>(p, l, it - 512, smem);
      }
#pragma unroll 1
      for (int it = bid; it < n; it += nb) {
        if (it < 512) attn_item<2>(p, l, it, smem);
        else if (it < 1024) attn_item<3>(p, l, it - 512, smem);
        else if (it < 1792) scan_item<0>(p, l, it - 1024);
        else scan_item<1>(p, l, it - 1792);
      }
    }
    xcd_barrier(xb);
#pragma unroll 1
    for (int rep = 0; rep < REP_P3C; ++rep)
#pragma unroll 1
    for (int it = bid; it < 2560; it += nb) {
      if (it < 1280) dout_item(p, l, it, smem);
      else cout_item(p, l, it - 1280, smem);
    }
    xcd_barrier(xb);
#pragma unroll 1
    for (int rep = 0; rep < REP_P4; ++rep)
#pragma unroll 1
    for (int it = bid; it < 1024; it += nb) gemm_out(p, it, smem);
    xcd_barrier(xb);
  }
  prep_phase<0>(p, 4, bid, nb);
}

extern "C" void kernel_launch(void* const* d_in, const int* in_sizes, int n_in, void* d_out, int out_size, void* d_ws,
                              size_t ws_size, hipStream_t stream) {
  static int grid_blocks = 0;
  if (!grid_blocks) {
    int dev = 0, cus = 0, per_cu = 0;
    hipGetDevice(&dev);
    hipDeviceGetAttribute(&cus, hipDeviceAttributeMultiprocessorCount, dev);
    hipFuncSetAttribute((const void*)mega, hipFuncAttributeMaxDynamicSharedMemorySize, LDS_BYTES);
    hipOccupancyMaxActiveBlocksPerMultiprocessor(&per_cu, (const void*)mega, 256, LDS_BYTES);
    if (per_cu < 1) per_cu = 1;
    if (per_cu > 2) per_cu = 2;
    grid_blocks = cus * per_cu;
  }
  Params p{};
  const float* const* in = (const float* const*)d_in;
  p.x_prompt = in[0]; p.x_sample = in[1]; p.c = in[2]; p.cwk = in[3]; p.cwv = in[4]; p.cnk = in[5]; p.cnv = in[6];
  p.st_ret = in[7]; p.st_hgrn = in[8]; p.c_ctx = in[9]; p.w_ada = in[10]; p.b_ada = in[11]; p.g_pre = in[12];
  p.g_post = in[13]; p.w_in = in[14]; p.w_out = in[15]; p.sink = in[16]; p.rpb = in[17]; p.ret_logit = in[18];
  p.lb_logit = in[19];
  p.out = (float*)d_out;
  unsigned char* ws = (unsigned char*)d_ws;
  size_t off = 0;
  p.wt_in = (u16*)(ws + off); off += (size_t)4096 * WS * 2;
  p.wt_out = (u16*)(ws + off); off += (size_t)1024 * WS * 2;
  p.hbuf = (u16*)(ws + off); off += (size_t)NTOK * HS * 2;
  p.proj = (u16*)(ws + off); p.ybuf = (u16*)(ws + off); off += (size_t)NTOK * 4096 * 2;
  p.uc = (u16*)(ws + off); off += (size_t)320 * 4 * 2 * 4096 * 2;
  p.ud = (u16*)(ws + off); off += (size_t)320 * 4 * 2 * 4096 * 2;
  p.dg = (float*)(ws + off); off += (size_t)320 * 4 * 2 * 64 * 4;
  p.mod = (float*)(ws + off); off += (size_t)4 * 9 * 3072 * 4;
  p.rope = (float*)(ws + off); off += (size_t)2048 * 32 * 2 * 4;
  p.bar = (unsigned*)(ws + off); off += (size_t)XCD_BAR_WORDS * 4;
  off = (off + 255) & ~(size_t)255;
  p.cbak = (u16*)(ws + off); off += (size_t)8 * 256 * 128 * 2;
  p.cbav = (u16*)(ws + off); off += (size_t)8 * 256 * 128 * 2;
  p.cbbk = (u16*)(ws + off); off += (size_t)8 * 256 * 256 * 2;
  p.cbbv = (u16*)(ws + off); off += (size_t)8 * 256 * 256 * 2;
  if (off > ws_size) { fprintf(stderr, "workspace too small: need %zu have %zu\n", off, ws_size); return; }
  if (hipMemsetAsync(p.bar, 0, (size_t)XCD_BAR_WORDS * 4, stream) != hipSuccess) { fprintf(stderr, "memset failed\n"); return; }
  void* args[] = {&p};
  hipError_t e = hipLaunchCooperativeKernel((const void*)mega, dim3(grid_blocks), dim3(256), args, LDS_BYTES, stream);
  if (e != hipSuccess) fprintf(stderr, "cooperative launch failed: %s (grid %d)\n", hipGetErrorString(e), grid_blocks);
}
```

```cpp
#include <hip/hip_runtime.h>
#include <hip/hip_cooperative_groups.h>
#include <cstdio>
#include <cstdint>
namespace cg = cooperative_groups;

typedef unsigned short u16;
typedef __attribute__((ext_vector_type(8))) short bf16x8;
typedef __attribute__((ext_vector_type(4))) float f32x4;

#define LOG2E 1.4426950408889634f
#define NTOK 20480
#define NCTX 4096
#define LDS_BYTES 75776
#define HS 1024
#define WS 1024
#ifndef REP_P1
#define REP_P1 1
#endif
#ifndef REP_SCAN
#define REP_SCAN 1
#endif
#ifndef REP_P2
#define REP_P2 1
#endif
#ifndef REP_P3A
#define REP_P3A 1
#endif
#ifndef REP_P3B
#define REP_P3B 1
#endif
#ifndef REP_P3C
#define REP_P3C 1
#endif
#ifndef REP_P4
#define REP_P4 1
#endif
#ifndef EXTRA_SYNC
#define EXTRA_SYNC 0
#endif

struct Params {
  const float *x_prompt, *x_sample, *c, *cwk, *cwv, *cnk, *cnv, *st_ret, *st_hgrn, *c_ctx,
      *w_ada, *b_ada, *g_pre, *g_post, *w_in, *w_out, *sink, *rpb, *ret_logit, *lb_logit;
  float* out;
  u16 *wt_in, *wt_out, *hbuf, *proj, *uc, *ud;
  float *dg, *mod, *rope;
  u16* ybuf;
  unsigned* bar;
  u16 *cbak, *cbav, *cbbk, *cbbv;
};

#define OUT_WK 20971520
#define OUT_WV 23068672
#define OUT_NK 25165824
#define OUT_NV 29360128
#define OUT_SR 33554432
#define OUT_SH 35651584

__device__ __forceinline__ int otid() { int t = threadIdx.x; asm volatile("" : "+v"(t)); return t; }
typedef __bf16 bf2_t __attribute__((ext_vector_type(2)));
__device__ __forceinline__ unsigned pack2(float a, float b) { bf2_t v; v[0] = (__bf16)a; v[1] = (__bf16)b; return __builtin_bit_cast(unsigned, v); }
__device__ __forceinline__ u16 f2bf(float f) { return (u16)(pack2(f, 0.f) & 0xffffu); }
__device__ __forceinline__ float bf2f(u16 h) { return __uint_as_float(((unsigned)h) << 16); }
__device__ __forceinline__ float bflo(unsigned u) { return __uint_as_float(u << 16); }
__device__ __forceinline__ float bfhi(unsigned u) { return __uint_as_float(u & 0xffff0000u); }
__device__ __forceinline__ float fexp2(float x) { return __builtin_amdgcn_exp2f(x); }
__device__ __forceinline__ float silu_f(float x) { return x / (1.f + __expf(-x)); }
__device__ __forceinline__ float wsum64(float v) {
#pragma unroll
  for (int o = 32; o >= 1; o >>= 1) v += __shfl_xor(v, o);
  return v;
}
#define DPPF(v, ctrl) __int_as_float(__builtin_amdgcn_update_dpp(0, __float_as_int(v), ctrl, 0xF, 0xF, true))
__device__ __forceinline__ float gsum16(float v) {
  v += DPPF(v, 0xB1); v += DPPF(v, 0x4E); v += DPPF(v, 0x141); v += DPPF(v, 0x140);
  return v;
}
__device__ __forceinline__ float gmax16(float v) {
  v = fmaxf(v, DPPF(v, 0xB1)); v = fmaxf(v, DPPF(v, 0x4E)); v = fmaxf(v, DPPF(v, 0x141)); v = fmaxf(v, DPPF(v, 0x140));
  return v;
}
__device__ __forceinline__ void wave_lds_sync() {
  __builtin_amdgcn_fence(__ATOMIC_RELEASE, "workgroup");
  __builtin_amdgcn_wave_barrier();
  __builtin_amdgcn_fence(__ATOMIC_ACQUIRE, "workgroup");
}
__device__ __forceinline__ f32x4 mfma16(bf16x8 a, bf16x8 b, f32x4 c) {
  return __builtin_amdgcn_mfma_f32_16x16x32_bf16(a, b, c, 0, 0, 0);
}
__device__ __forceinline__ bf16x8 ld8(const u16* p) { return *reinterpret_cast<const bf16x8*>(p); }

__device__ __forceinline__ float ret_lg2(const Params& p, int l, int dir, int h) {
  float x = p.ret_logit[(l * 2 + dir) * 4 + h];
  return -log1pf(expf(-x)) * LOG2E;
}
__device__ __forceinline__ float hgrn_lb(const Params& p, int l, int dir, int ch256) {
  float a0 = p.lb_logit[(0 * 2 + dir) * 256 + ch256], a1 = p.lb_logit[(1 * 2 + dir) * 256 + ch256];
  float a2 = p.lb_logit[(2 * 2 + dir) * 256 + ch256], a3 = p.lb_logit[(3 * 2 + dir) * 256 + ch256];
  float mx = fmaxf(fmaxf(a0, a1), fmaxf(a2, a3));
  float e0 = expf(a0 - mx), e1 = expf(a1 - mx), e2 = expf(a2 - mx), e3 = expf(a3 - mx);
  float inv = 1.f / (e0 + e1 + e2 + e3);
  float s = 0.f;
  if (l >= 1) s += e1;
  if (l >= 2) s += e2;
  if (l >= 3) s += e3;
  return s * inv;
}

__device__ void adaln_item(const Params& p, int it, unsigned char* smem) {
  float* sv = (float*)smem;
  float* red = sv + 9 * 1024;
  const int tid = otid(), w = tid >> 6, lane = tid & 63;
  const int l = it / 48, cb = (it % 48) * 64;
  __syncthreads();
  for (int i = tid; i < 9 * 1024; i += 256) {
    int v = i >> 10, k = i & 1023;
    float cv = v < 8 ? p.c[v * 1024 + k] : p.c_ctx[k];
    sv[i] = cv / (1.f + expf(-cv));
  }
  __syncthreads();
  const int col = cb + lane;
  const float* W = p.w_ada + (size_t)l * 1024 * 3072 + col;
  float acc[9];
#pragma unroll
  for (int v = 0; v < 9; ++v) acc[v] = 0.f;
#pragma unroll 1
  for (int k0 = w * 256; k0 < w * 256 + 256; k0 += 16) {
    float wv[16];
#pragma unroll
    for (int i = 0; i < 16; ++i) wv[i] = W[(size_t)(k0 + i) * 3072];
#pragma unroll
    for (int i = 0; i < 16; ++i)
#pragma unroll
      for (int v = 0; v < 9; ++v) acc[v] += sv[v * 1024 + k0 + i] * wv[i];
  }
#pragma unroll
  for (int v = 0; v < 9; ++v) red[(w * 9 + v) * 64 + lane] = acc[v];
  __syncthreads();
  if (tid < 64) {
    float bb = p.b_ada[l * 3072 + col];
#pragma unroll
    for (int v = 0; v < 9; ++v) {
      float s = red[(0 * 9 + v) * 64 + lane] + red[(1 * 9 + v) * 64 + lane] + red[(2 * 9 + v) * 64 + lane] + red[(3 * 9 + v) * 64 + lane];
      p.mod[(l * 9 + v) * 3072 + col] = s + bb;
    }
  }
  __syncthreads();
}

__device__ void rope_item(const Params& p, int it) {
  int idx = it * 256 + otid();
  int s = idx >> 5, i = idx & 31, fi = i & 15;
  float freq = powf(10000.f, -(float)fi / 16.f);
  int pos = (i < 16) ? (s >> 6) : (s & 63);
  float ang = (float)pos * freq;
  p.rope[idx * 2] = cosf(ang);
  p.rope[idx * 2 + 1] = sinf(ang);
}

__device__ void conv_tile(const float* src, int N, u16* dst, int tile, unsigned char* smem) {
  float* t = (float*)smem;
  const int tid = otid();
  const int ntn = N >> 6;
  const int k0 = (tile / ntn) * 64, n0 = (tile % ntn) * 64;
  __syncthreads();
#pragma unroll
  for (int r = 0; r < 16; ++r) {
    int row = r * 4 + (tid >> 6), col = tid & 63;
    t[row * 65 + col] = src[(size_t)(k0 + row) * N + n0 + col];
  }
  __syncthreads();
#pragma unroll
  for (int r = 0; r < 8; ++r) {
    int n = r * 8 + (tid >> 5), kp = tid & 31;
    unsigned v = pack2(t[(2 * kp) * 65 + n], t[(2 * kp + 1) * 65 + n]);
    *reinterpret_cast<unsigned*>(dst + (size_t)(n0 + n) * WS + k0 + 2 * kp) = v;
  }
  __syncthreads();
}


__device__ void cache_conv_item(const Params& p, int l, int it) {
  const int tid = otid();
  const float* src; u16* dst; int W, e0;
  if (it < 128) { src = p.cwk; dst = p.cbak; W = 128; e0 = it * 2048; }
  else if (it < 256) { src = p.cwv; dst = p.cbav; W = 128; e0 = (it - 128) * 2048; }
  else if (it < 512) { src = p.cnk; dst = p.cbbk; W = 256; e0 = (it - 256) * 2048; }
  else { src = p.cnv; dst = p.cbbv; W = 256; e0 = (it - 512) * 2048; }
  const int e = e0 + tid * 8;
  const int per_b = 256 * W, b = e / per_b, r = e - b * per_b;
  const float* sp = src + (size_t)((b * 4 + l) * 256) * W + r;
  float4 a = *reinterpret_cast<const float4*>(sp), c = *reinterpret_cast<const float4*>(sp + 4);
  uint4 o;
  o.x = pack2(a.x, a.y); o.y = pack2(a.z, a.w); o.z = pack2(c.x, c.y); o.w = pack2(c.z, c.w);
  *reinterpret_cast<uint4*>(dst + e) = o;
}
struct PrepRow { float4 x[4]; uint2 y[4]; float4 g[4], sh[4], sc[4]; };
__device__ __forceinline__ void prep_issue(const Params& p, int l, int T, int lane, PrepRow& r) {
  const int v = T < NCTX ? 8 : ((T - NCTX) >> 11);
  const float* xin = (l <= 1) ? (T < NCTX ? p.x_prompt + (size_t)T * 1024 : p.x_sample + (size_t)(T - NCTX) * 1024)
                              : p.out + (size_t)T * 1024;
#pragma unroll
  for (int i = 0; i < 4; ++i) r.x[i] = *reinterpret_cast<const float4*>(xin + (i * 64 + lane) * 4);
  if (l > 0) {
    const u16* yr = p.ybuf + (size_t)T * 1024;
    const float* gate = p.mod + ((l - 1) * 9 + v) * 3072 + 2048;
#pragma unroll
    for (int i = 0; i < 4; ++i) {
      const int col = (i * 64 + lane) * 4;
      r.y[i] = *reinterpret_cast<const uint2*>(yr + col);
      r.g[i] = *reinterpret_cast<const float4*>(gate + col);
    }
  }
  if (l < 4) {
    const float* md = p.mod + (l * 9 + v) * 3072;
#pragma unroll
    for (int i = 0; i < 4; ++i) {
      const int col = (i * 64 + lane) * 4;
      r.sh[i] = *reinterpret_cast<const float4*>(md + col);
      r.sc[i] = *reinterpret_cast<const float4*>(md + 1024 + col);
    }
  }
}
template <int DRY>
__device__ void prep_phase(const Params& p, int l, int bid, int nb) {
  const int tid = otid(), w = tid >> 6, lane = tid & 63;
  const int tstep = nb * 4;
  int T = bid * 4 + w;
  if (T >= NTOK) return;
  float4 pq[4], pgp[4];
#pragma unroll
  for (int i = 0; i < 4; ++i) {
    const int col = (i * 64 + lane) * 4;
    if (l > 0) pq[i] = *reinterpret_cast<const float4*>(p.g_post + (l - 1) * 1024 + col);
    if (l < 4) pgp[i] = *reinterpret_cast<const float4*>(p.g_pre + l * 1024 + col);
  }
  PrepRow cur, nxt;
  prep_issue(p, l, T, lane, nxt);
#pragma unroll 1
  for (; T < NTOK; T += tstep) {
    cur = nxt;
    if (T + tstep < NTOK) prep_issue(p, l, T + tstep, lane, nxt);
    float4 xv[4];
#pragma unroll
    for (int i = 0; i < 4; ++i) xv[i] = cur.x[i];
    if (l > 0) {
      float4 yv[4];
      float ss = 0.f;
#pragma unroll
      for (int i = 0; i < 4; ++i) {
        yv[i] = make_float4(bflo(cur.y[i].x), bfhi(cur.y[i].x), bflo(cur.y[i].y), bfhi(cur.y[i].y));
        ss += yv[i].x * yv[i].x + yv[i].y * yv[i].y + yv[i].z * yv[i].z + yv[i].w * yv[i].w;
      }
      ss = wsum64(ss);
      const float rstd = rsqrtf(ss * (1.f / 1024.f) + 1e-6f);
#pragma unroll
      for (int i = 0; i < 4; ++i) {
        const int col = (i * 64 + lane) * 4;
        xv[i].x += cur.g[i].x * (yv[i].x * rstd * pq[i].x);
        xv[i].y += cur.g[i].y * (yv[i].y * rstd * pq[i].y);
        xv[i].z += cur.g[i].z * (yv[i].z * rstd * pq[i].z);
        xv[i].w += cur.g[i].w * (yv[i].w * rstd * pq[i].w);
        if (!DRY) *reinterpret_cast<float4*>(p.out + (size_t)T * 1024 + col) = xv[i];
      }
    }
    if (l < 4) {
      float ss = 0.f;
#pragma unroll
      for (int i = 0; i < 4; ++i) ss += xv[i].x * xv[i].x + xv[i].y * xv[i].y + xv[i].z * xv[i].z + xv[i].w * xv[i].w;
      ss = wsum64(ss);
      const float rstd = rsqrtf(ss * (1.f / 1024.f) + 1e-6f);
#pragma unroll
      for (int i = 0; i < 4; ++i) {
        const int col = (i * 64 + lane) * 4;
        const float h0 = xv[i].x * rstd * pgp[i].x * (1.f + cur.sc[i].x) + cur.sh[i].x;
        const float h1 = xv[i].y * rstd * pgp[i].y * (1.f + cur.sc[i].y) + cur.sh[i].y;
        const float h2 = xv[i].z * rstd * pgp[i].z * (1.f + cur.sc[i].z) + cur.sh[i].z;
        const float h3 = xv[i].w * rstd * pgp[i].w * (1.f + cur.sc[i].w) + cur.sh[i].w;
        uint2 o;
        o.x = pack2(h0, h1);
        o.y = pack2(h2, h3);
        *reinterpret_cast<uint2*>(p.hbuf + (size_t)T * HS + col) = o;
      }
    }
  }
}

template <int MODE>
__device__ void gemm_tile(const Params& p, int l, int tile, unsigned char* smem) {
  u16* As = (u16*)smem;
  u16* Bs = As + 128 * 72;
  const int tid = otid(), w = tid >> 6, lane = tid & 63, r16 = lane & 15, quad = lane >> 4;
  const int wr = w >> 1, wc = w & 1;
  const int ntn = (MODE == 0) ? 32 : 8;
  const int ntm = (MODE == 0) ? 160 : 160;
  const int tm = tile % ntm, tn = tile / ntm;
  const u16* Agp = p.hbuf + (size_t)(tm * 128) * HS;
  const u16* Bgp = ((MODE == 0) ? p.wt_in : p.wt_out) + (size_t)(tn * 128) * WS;
  f32x4 acc[4][4];
#pragma unroll
  for (int a = 0; a < 4; ++a)
#pragma unroll
    for (int b = 0; b < 4; ++b) acc[a][b] = (f32x4){0.f, 0.f, 0.f, 0.f};
  const int lrow = tid >> 3, lkc = (tid & 7) * 8;
  const unsigned voff_Agp = lrow * HS + lkc, voff_Bgp = lrow * WS + lkc;
  u16* Asp = As + lrow * 72 + lkc;
  u16* Bsp = Bs + lrow * 72 + lkc;
  uint4 ra0, ra1, ra2, ra3, rb0, rb1, rb2, rb3;
#define GLD(p_, r_, S_) *reinterpret_cast<const uint4*>((p_) + ((size_t)(r_) * 32 * S_ + kofs) + voff_##p_)
#define GLOAD(KO) { const int kofs = (KO); \
  ra0 = GLD(Agp, 0, HS); ra1 = GLD(Agp, 1, HS); ra2 = GLD(Agp, 2, HS); ra3 = GLD(Agp, 3, HS); \
  rb0 = GLD(Bgp, 0, WS); rb1 = GLD(Bgp, 1, WS); rb2 = GLD(Bgp, 2, WS); rb3 = GLD(Bgp, 3, WS); }
#define SST(p_, st_, r_, v_) *reinterpret_cast<uint4*>((p_) + (st_) * (2 * 128 * 72) + (r_) * 32 * 72) = v_
#define STORE(st_) { SST(Asp, st_, 0, ra0); SST(Asp, st_, 1, ra1); SST(Asp, st_, 2, ra2); SST(Asp, st_, 3, ra3); \
                     SST(Bsp, st_, 0, rb0); SST(Bsp, st_, 1, rb1); SST(Bsp, st_, 2, rb2); SST(Bsp, st_, 3, rb3); }
  __syncthreads();
  GLOAD(0)
  STORE(0)
  GLOAD(64)
  __syncthreads();
#pragma unroll 1
  for (int kt = 0; kt < 16; ++kt) {
    const int cur = kt & 1;
    if (kt + 1 < 16) STORE(cur ^ 1)
    if (kt + 2 < 16) GLOAD((kt + 2) * 64)
    const u16* Ac = As + cur * (2 * 128 * 72);
    const u16* Bc = Bs + cur * (2 * 128 * 72);
    __builtin_amdgcn_s_setprio(1);
#pragma unroll
    for (int ks = 0; ks < 2; ++ks) {
      bf16x8 wf[4], xf[4];
#pragma unroll
      for (int i = 0; i < 4; ++i) {
        wf[i] = ld8(Bc + (wc * 64 + i * 16 + r16) * 72 + ks * 32 + quad * 8);
        xf[i] = ld8(Ac + (wr * 64 + i * 16 + r16) * 72 + ks * 32 + quad * 8);
      }
#pragma unroll
      for (int nt = 0; nt < 4; ++nt)
#pragma unroll
        for (int mt = 0; mt < 4; ++mt) acc[nt][mt] = mfma16(wf[nt], xf[mt], acc[nt][mt]);
    }
    __builtin_amdgcn_s_setprio(0);
    __syncthreads();
  }
#undef GLD
#undef GLOAD
#undef SST
#undef STORE
  const int colbase = tn * 128 + wc * 64;
  if (MODE == 0) {
    const bool ropeseg = (colbase < 384) || (colbase >= 1792 && colbase < 2304);
#pragma unroll
    for (int mt = 0; mt < 4; ++mt) {
      const int T = tm * 128 + wr * 64 + mt * 16 + r16;
      const bool lat = T >= NCTX;
      if (ropeseg && lat) {
        const int s = (T - NCTX) & 2047;
        const float* rp = p.rope + (size_t)(s * 32 + quad * 4) * 2;
        float4 c0 = *reinterpret_cast<const float4*>(rp);
        float4 c1 = *reinterpret_cast<const float4*>(rp + 4);
        float4 d0 = *reinterpret_cast<const float4*>(rp + 32);
        float4 d1 = *reinterpret_cast<const float4*>(rp + 36);
        float cs[4] = {c0.x, c0.z, c1.x, c1.z}, sn[4] = {c0.y, c0.w, c1.y, c1.w};
        float cs2[4] = {d0.x, d0.z, d1.x, d1.z}, sn2[4] = {d0.y, d0.w, d1.y, d1.w};
#pragma unroll
        for (int j = 0; j < 4; ++j) {
          float x1 = acc[0][mt][j], x2 = acc[1][mt][j];
          acc[0][mt][j] = x1 * cs[j] - x2 * sn[j];
          acc[1][mt][j] = x2 * cs[j] + x1 * sn[j];
          float y1 = acc[2][mt][j], y2 = acc[3][mt][j];
          acc[2][mt][j] = y1 * cs2[j] - y2 * sn2[j];
          acc[3][mt][j] = y2 * cs2[j] + y1 * sn2[j];
        }
      }
#pragma unroll
      for (int nt = 0; nt < 4; ++nt) {
        const int col = colbase + nt * 16 + quad * 4;
        uint2 o;
        o.x = pack2(acc[nt][mt][0], acc[nt][mt][1]);
        o.y = pack2(acc[nt][mt][2], acc[nt][mt][3]);
        *reinterpret_cast<uint2*>(p.proj + (size_t)T * 4096 + col) = o;
        if (!lat) {
          const int b = T >> 8, s = T & 255;
          float4 f = {acc[nt][mt][0], acc[nt][mt][1], acc[nt][mt][2], acc[nt][mt][3]};
          const size_t rowi = (size_t)((b * 4 + l) * 256 + s);
          if (col >= 256 && col < 384) *reinterpret_cast<float4*>(p.out + OUT_WK + rowi * 128 + (col - 256)) = f;
          else if (col >= 384 && col < 512) *reinterpret_cast<float4*>(p.out + OUT_WV + rowi * 128 + (col - 384)) = f;
          else if (col >= 1024 && col < 1280) *reinterpret_cast<float4*>(p.out + OUT_NK + rowi * 256 + (col - 1024)) = f;
          else if (col >= 1280 && col < 1536) *reinterpret_cast<float4*>(p.out + OUT_NV + rowi * 256 + (col - 1280)) = f;
        }
      }
    }
  } else {
#pragma unroll
    for (int mt = 0; mt < 4; ++mt) {
      const int T = tm * 128 + wr * 64 + mt * 16 + r16;
#pragma unroll
      for (int nt = 0; nt < 4; ++nt) {
        const int col = colbase + nt * 16 + quad * 4;
        uint2 o;
        o.x = pack2(acc[nt][mt][0], acc[nt][mt][1]);
        o.y = pack2(acc[nt][mt][2], acc[nt][mt][3]);
        *reinterpret_cast<uint2*>(p.ybuf + (size_t)T * 1024 + col) = o;
      }
    }
  }
}

__device__ void gemm_out(const Params& p, int tile, unsigned char* smem) {
  u16* As = (u16*)smem;
  u16* Bs = As + 160 * 72;
  const int tid = otid(), w = tid >> 6, lane = tid & 63, r16 = lane & 15, quad = lane >> 4;
  const int wr = w >> 1, wc = w & 1;
  const int tm = tile & 127, tn = tile >> 7;
  const u16* Agp = p.hbuf + (size_t)(tm * 160) * HS;
  const u16* Bgp = p.wt_out + (size_t)(tn * 128) * WS;
  f32x4 acc[4][5];
#pragma unroll
  for (int a = 0; a < 4; ++a)
#pragma unroll
    for (int b = 0; b < 5; ++b) acc[a][b] = (f32x4){0.f, 0.f, 0.f, 0.f};
  const int lrow = tid >> 3, lkc = (tid & 7) * 8;
  const unsigned voff_Agp = lrow * HS + lkc, voff_Bgp = lrow * WS + lkc;
  u16* Asp = As + lrow * 72 + lkc;
  u16* Bsp = Bs + lrow * 72 + lkc;
  uint4 ra0, ra1, ra2, ra3, ra4, rb0, rb1, rb2, rb3;
#define GLD(p_, r_, S_) *reinterpret_cast<const uint4*>((p_) + ((size_t)(r_) * 32 * S_ + kofs) + voff_##p_)
#define GLOADO(KO) { const int kofs = (KO); \
  ra0 = GLD(Agp, 0, HS); ra1 = GLD(Agp, 1, HS); ra2 = GLD(Agp, 2, HS); ra3 = GLD(Agp, 3, HS); ra4 = GLD(Agp, 4, HS); \
  rb0 = GLD(Bgp, 0, WS); rb1 = GLD(Bgp, 1, WS); rb2 = GLD(Bgp, 2, WS); rb3 = GLD(Bgp, 3, WS); }
#define SST(p_, r_, v_) *reinterpret_cast<uint4*>((p_) + (r_) * 32 * 72) = v_
  GLOADO(0)
#pragma unroll 1
  for (int kt = 0; kt < 16; ++kt) {
    __syncthreads();
    SST(Asp, 0, ra0); SST(Asp, 1, ra1); SST(Asp, 2, ra2); SST(Asp, 3, ra3); SST(Asp, 4, ra4);
    SST(Bsp, 0, rb0); SST(Bsp, 1, rb1); SST(Bsp, 2, rb2); SST(Bsp, 3, rb3);
    if (kt + 1 < 16) GLOADO((kt + 1) * 64)
    __syncthreads();
    {
      bf16x8 wf0[4], xf0[5], wf1[4], xf1[5];
#pragma unroll
      for (int i = 0; i < 4; ++i) wf0[i] = ld8(Bs + (wc * 64 + i * 16 + r16) * 72 + quad * 8);
#pragma unroll
      for (int i = 0; i < 5; ++i) xf0[i] = ld8(As + (wr * 80 + i * 16 + r16) * 72 + quad * 8);
#pragma unroll
      for (int i = 0; i < 4; ++i) wf1[i] = ld8(Bs + (wc * 64 + i * 16 + r16) * 72 + 32 + quad * 8);
#pragma unroll
      for (int i = 0; i < 5; ++i) xf1[i] = ld8(As + (wr * 80 + i * 16 + r16) * 72 + 32 + quad * 8);
      __builtin_amdgcn_sched_barrier(0);
      __builtin_amdgcn_s_setprio(1);
#pragma unroll
      for (int mt = 0; mt < 5; ++mt)
#pragma unroll
        for (int nt = 0; nt < 4; ++nt) acc[nt][mt] = mfma16(wf0[nt], xf0[mt], acc[nt][mt]);
#pragma unroll
      for (int mt = 0; mt < 5; ++mt)
#pragma unroll
        for (int nt = 0; nt < 4; ++nt) acc[nt][mt] = mfma16(wf1[nt], xf1[mt], acc[nt][mt]);
      __builtin_amdgcn_s_setprio(0);
    }
  }
#undef GLD
#undef GLOADO
#undef SST
  const int colbase = tn * 128 + wc * 64;
#pragma unroll
  for (int mt = 0; mt < 5; ++mt) {
    const int T = tm * 160 + wr * 80 + mt * 16 + r16;
#pragma unroll
    for (int nt = 0; nt < 4; ++nt) {
      const int col = colbase + nt * 16 + quad * 4;
      uint2 o;
      o.x = pack2(acc[nt][mt][0], acc[nt][mt][1]);
      o.y = pack2(acc[nt][mt][2], acc[nt][mt][3]);
      *reinterpret_cast<uint2*>(p.ybuf + (size_t)T * 1024 + col) = o;
    }
  }
}

__device__ void gemm_big(const Params& p, int l, int tile, unsigned char* smem) {
  u16* As = (u16*)smem;
  u16* Bs = As + 256 * 72;
  const int tid = otid(), w = tid >> 6, lane = tid & 63, r16 = lane & 15, quad = lane >> 4;
  const int wr = w >> 1, wc = w & 1;
  int tm, tn;
  {
    const int r = tile >> 9, x = tile & 7, sl = (tile & 511) >> 3;
    const int R = r * 8 + x;
    tm = (R % 10) * 8 + (sl & 7);
    tn = (R / 10) * 8 + (sl >> 3);
  }
  const u16* Ag = p.hbuf + (size_t)(tm * 256) * HS;
  const u16* Bg = p.wt_in + (size_t)(tn * 128) * WS;
  f32x4 acc[4][8];
#pragma unroll
  for (int a = 0; a < 4; ++a)
#pragma unroll
    for (int b = 0; b < 8; ++b) acc[a][b] = (f32x4){0.f, 0.f, 0.f, 0.f};
  const int lrow = tid >> 3, lkc = (tid & 7) * 8;
  const u16* Agp = Ag + (size_t)lrow * HS + lkc;
  const u16* Bgp = Bg + (size_t)lrow * WS + lkc;
  u16* Asp = As + lrow * 72 + lkc;
  u16* Bsp = Bs + lrow * 72 + lkc;
  uint4 ra0, ra1, ra2, ra3, ra4, ra5, ra6, ra7, rb0, rb1, rb2, rb3;
#define GLD(p_, r_, S_) *reinterpret_cast<const uint4*>((p_) + (size_t)(r_) * 32 * S_ + kofs)
#define GLOADB(KO) { const int kofs = (KO); \
  ra0 = GLD(Agp, 0, HS); ra1 = GLD(Agp, 1, HS); ra2 = GLD(Agp, 2, HS); ra3 = GLD(Agp, 3, HS); ra4 = GLD(Agp, 4, HS); ra5 = GLD(Agp, 5, HS); ra6 = GLD(Agp, 6, HS); ra7 = GLD(Agp, 7, HS); \
  rb0 = GLD(Bgp, 0, WS); rb1 = GLD(Bgp, 1, WS); rb2 = GLD(Bgp, 2, WS); rb3 = GLD(Bgp, 3, WS); }
#define SST(p_, r_, v_) *reinterpret_cast<uint4*>((p_) + (r_) * 32 * 72) = v_
  GLOADB(0)
#pragma unroll 1
  for (int kt = 0; kt < 16; ++kt) {
    __syncthreads();
    SST(Asp, 0, ra0); SST(Asp, 1, ra1); SST(Asp, 2, ra2); SST(Asp, 3, ra3); SST(Asp, 4, ra4); SST(Asp, 5, ra5); SST(Asp, 6, ra6); SST(Asp, 7, ra7);
    SST(Bsp, 0, rb0); SST(Bsp, 1, rb1); SST(Bsp, 2, rb2); SST(Bsp, 3, rb3);
    if (kt + 1 < 16) GLOADB((kt + 1) * 64)
    __syncthreads();
    {
      const u16* Bb = Bs + (wc * 64 + r16) * 72 + quad * 8;
      const u16* Ab = As + (wr * 128 + r16) * 72 + quad * 8;
      bf16x8 wf0[4], wf1[4], xr[3];
#pragma unroll
      for (int i = 0; i < 4; ++i) wf0[i] = ld8(Bb + i * 16 * 72);
#pragma unroll
      for (int i = 0; i < 2; ++i) xr[i] = ld8(Ab + i * 16 * 72);
#pragma unroll
      for (int i = 0; i < 4; ++i) wf1[i] = ld8(Bb + i * 16 * 72 + 32);
      __builtin_amdgcn_sched_barrier(0);
      __builtin_amdgcn_s_setprio(1);
#pragma unroll
      for (int st = 0; st < 16; ++st) {
        const int nx = st + 2;
        if (nx < 16) xr[nx % 3] = ld8(Ab + (nx & 7) * 16 * 72 + (nx >> 3) * 32);
        __builtin_amdgcn_sched_barrier(0);
        const int mt = st & 7;
        if (st < 8) {
#pragma unroll
          for (int nt = 0; nt < 4; ++nt) acc[nt][mt] = mfma16(wf0[nt], xr[st % 3], acc[nt][mt]);
        } else {
#pragma unroll
          for (int nt = 0; nt < 4; ++nt) acc[nt][mt] = mfma16(wf1[nt], xr[st % 3], acc[nt][mt]);
        }
        __builtin_amdgcn_sched_barrier(0);
      }
      __builtin_amdgcn_s_setprio(0);
    }
  }
#undef GLD
#undef GLOADB
#undef SST
  const int colbase = tn * 128 + wc * 64;
  const bool ropeseg = (colbase < 384) || (colbase >= 1792 && colbase < 2304);
  __syncthreads();
  u16* stg = (u16*)smem + w * (64 * 72);
#pragma unroll
  for (int half = 0; half < 2; ++half) {
#pragma unroll
    for (int mtl = 0; mtl < 4; ++mtl) {
      const int mt = half * 4 + mtl;
      const int T = tm * 256 + wr * 128 + mt * 16 + r16;
      const bool lat = T >= NCTX;
      if (ropeseg && lat) {
        const int s = (T - NCTX) & 2047;
        const float* rp = p.rope + (size_t)(s * 32 + quad * 4) * 2;
        float4 c0 = *reinterpret_cast<const float4*>(rp);
        float4 c1 = *reinterpret_cast<const float4*>(rp + 4);
        float4 d0 = *reinterpret_cast<const float4*>(rp + 32);
        float4 d1 = *reinterpret_cast<const float4*>(rp + 36);
        float cs[4] = {c0.x, c0.z, c1.x, c1.z}, sn[4] = {c0.y, c0.w, c1.y, c1.w};
        float cs2[4] = {d0.x, d0.z, d1.x, d1.z}, sn2[4] = {d0.y, d0.w, d1.y, d1.w};
#pragma unroll
        for (int j = 0; j < 4; ++j) {
          float x1 = acc[0][mt][j], x2 = acc[1][mt][j];
          acc[0][mt][j] = x1 * cs[j] - x2 * sn[j];
          acc[1][mt][j] = x2 * cs[j] + x1 * sn[j];
          float y1 = acc[2][mt][j], y2 = acc[3][mt][j];
          acc[2][mt][j] = y1 * cs2[j] - y2 * sn2[j];
          acc[3][mt][j] = y2 * cs2[j] + y1 * sn2[j];
        }
      }
#pragma unroll
      for (int nt = 0; nt < 4; ++nt) {
        uint2 o;
        o.x = pack2(acc[nt][mt][0], acc[nt][mt][1]);
        o.y = pack2(acc[nt][mt][2], acc[nt][mt][3]);
        *reinterpret_cast<uint2*>(stg + (mtl * 16 + r16) * 72 + nt * 16 + quad * 4) = o;
        if (!lat) {
          const int col = colbase + nt * 16 + quad * 4;
          const int b = T >> 8, s = T & 255;
          float4 f = {acc[nt][mt][0], acc[nt][mt][1], acc[nt][mt][2], acc[nt][mt][3]};
          const size_t rowi = (size_t)((b * 4 + l) * 256 + s);
          if (col >= 256 && col < 384) *reinterpret_cast<float4*>(p.out + OUT_WK + rowi * 128 + (col - 256)) = f;
          else if (col >= 384 && col < 512) *reinterpret_cast<float4*>(p.out + OUT_WV + rowi * 128 + (col - 384)) = f;
          else if (col >= 1024 && col < 1280) *reinterpret_cast<float4*>(p.out + OUT_NK + rowi * 256 + (col - 1024)) = f;
          else if (col >= 1280 && col < 1536) *reinterpret_cast<float4*>(p.out + OUT_NV + rowi * 256 + (col - 1280)) = f;
        }
      }
    }
    wave_lds_sync();
#pragma unroll
    for (int i = 0; i < 8; ++i) {
      const int row = i * 8 + (lane >> 3), ch = lane & 7;
      uint4 v = *reinterpret_cast<const uint4*>(stg + row * 72 + ch * 8);
      const int T = tm * 256 + wr * 128 + half * 64 + row;
      *reinterpret_cast<uint4*>(p.proj + (size_t)T * 4096 + colbase + ch * 8) = v;
    }
    wave_lds_sync();
  }
}

__device__ __forceinline__ void ld_rows_bf16(u16* dst, const u16* src, size_t stride) {
  const int tid = otid(), row = tid >> 2, part = (tid & 3) * 16;
  const u16* s = src + (size_t)row * stride + part;
  uint4 a = *reinterpret_cast<const uint4*>(s);
  uint4 b = *reinterpret_cast<const uint4*>(s + 8);
  *reinterpret_cast<uint4*>(dst + row * 72 + part) = a;
  *reinterpret_cast<uint4*>(dst + row * 72 + part + 8) = b;
}
__device__ __forceinline__ void ld_rows_f32(u16* dst, const float* src, size_t stride) {
  const int tid = otid(), row = tid >> 2, part = (tid & 3) * 16;
  const float* s = src + (size_t)row * stride + part;
  float4 a = *reinterpret_cast<const float4*>(s), b = *reinterpret_cast<const float4*>(s + 4);
  float4 c = *reinterpret_cast<const float4*>(s + 8), d = *reinterpret_cast<const float4*>(s + 12);
  uint4 o0, o1;
  o0.x = pack2(a.x, a.y); o0.y = pack2(a.z, a.w); o0.z = pack2(b.x, b.y); o0.w = pack2(b.z, b.w);
  o1.x = pack2(c.x, c.y); o1.y = pack2(c.z, c.w); o1.z = pack2(d.x, d.y); o1.w = pack2(d.z, d.w);
  *reinterpret_cast<uint4*>(dst + row * 72 + part) = o0;
  *reinterpret_cast<uint4*>(dst + row * 72 + part + 8) = o1;
}
__device__ __forceinline__ void ld_tr_bf16(u16* dst, const u16* src, size_t stride) {
  const int tid = otid(), dc = tid >> 5, kp = tid & 31;
  uint4 a = *reinterpret_cast<const uint4*>(src + (size_t)(2 * kp) * stride + dc * 8);
  uint4 b = *reinterpret_cast<const uint4*>(src + (size_t)(2 * kp + 1) * stride + dc * 8);
  unsigned av[4] = {a.x, a.y, a.z, a.w}, bv[4] = {b.x, b.y, b.z, b.w};
#pragma unroll
  for (int i = 0; i < 4; ++i) {
    unsigned lo = (av[i] & 0xffffu) | (bv[i] << 16);
    unsigned hi = (av[i] >> 16) | (bv[i] & 0xffff0000u);
    *reinterpret_cast<unsigned*>(dst + (dc * 8 + 2 * i) * 72 + 2 * kp) = lo;
    *reinterpret_cast<unsigned*>(dst + (dc * 8 + 2 * i + 1) * 72 + 2 * kp) = hi;
  }
}
__device__ __forceinline__ void ld_tr_f32(u16* dst, const float* src, size_t stride) {
  const int tid = otid(), dc = tid >> 5, kp = tid & 31;
  const float* s0 = src + (size_t)(2 * kp) * stride + dc * 8;
  const float* s1 = src + (size_t)(2 * kp + 1) * stride + dc * 8;
  float4 a0 = *reinterpret_cast<const float4*>(s0), a1 = *reinterpret_cast<const float4*>(s0 + 4);
  float4 b0 = *reinterpret_cast<const float4*>(s1), b1 = *reinterpret_cast<const float4*>(s1 + 4);
  float av[8] = {a0.x, a0.y, a0.z, a0.w, a1.x, a1.y, a1.z, a1.w};
  float bv[8] = {b0.x, b0.y, b0.z, b0.w, b1.x, b1.y, b1.z, b1.w};
#pragma unroll
  for (int i = 0; i < 8; ++i) *reinterpret_cast<unsigned*>(dst + (dc * 8 + i) * 72 + 2 * kp) = pack2(av[i], bv[i]);
}

#define DEFER_THR 10.0f
template <int NSUB, class F>
__device__ __forceinline__ void attn_step(const u16* Ksh, const u16* Vt, int kbeg, const bf16x8 (&aq)[2],
                                          f32x4 (&o)[4], float& m, float& ls, F maskf, int r16, int quad) {
  f32x4 st[NSUB];
#pragma unroll
  for (int t = 0; t < NSUB; ++t) {
    st[t] = (f32x4){0.f, 0.f, 0.f, 0.f};
#pragma unroll
    for (int ks = 0; ks < 2; ++ks) st[t] = mfma16(ld8(Ksh + (kbeg + t * 16 + r16) * 72 + ks * 32 + quad * 8), aq[ks], st[t]);
  }
  float mx = -1e30f;
#pragma unroll
  for (int t = 0; t < NSUB; ++t)
#pragma unroll
    for (int j = 0; j < 4; ++j) {
      st[t][j] = maskf(kbeg + t * 16 + quad * 4 + j, st[t][j] * (0.125f * LOG2E));
      mx = fmaxf(mx, st[t][j]);
    }
  mx = fmaxf(mx, __shfl_xor(mx, 16));
  mx = fmaxf(mx, __shfl_xor(mx, 32));
  float al = 1.f;
  __builtin_amdgcn_sched_barrier(0);
  if (__any(mx - m > DEFER_THR)) {
    const float mn = fmaxf(m, mx);
    al = fexp2(m - mn);
    m = mn;
#pragma unroll
    for (int n = 0; n < 4; ++n)
#pragma unroll
      for (int j = 0; j < 4; ++j) o[n][j] *= al;
  }
  __builtin_amdgcn_sched_barrier(0);
  float rs = 0.f;
#pragma unroll
  for (int t = 0; t < NSUB; ++t)
#pragma unroll
    for (int j = 0; j < 4; ++j) {
      float pv = fexp2(st[t][j] - m);
      st[t][j] = pv;
      rs += pv;
    }
  ls = ls * al + rs;
#pragma unroll
  for (int s2 = 0; s2 < NSUB / 2; ++s2) {
    union { unsigned u[4]; bf16x8 v; } bp;
    bp.u[0] = pack2(st[2 * s2][0], st[2 * s2][1]);
    bp.u[1] = pack2(st[2 * s2][2], st[2 * s2][3]);
    bp.u[2] = pack2(st[2 * s2 + 1][0], st[2 * s2 + 1][1]);
    bp.u[3] = pack2(st[2 * s2 + 1][2], st[2 * s2 + 1][3]);
#pragma unroll
    for (int n = 0; n < 4; ++n) {
      const u16* vp = Vt + (n * 16 + r16) * 72 + kbeg + s2 * 32 + quad * 4;
      union { uint2 h[2]; bf16x8 v; } av;
      av.h[0] = *reinterpret_cast<const uint2*>(vp);
      av.h[1] = *reinterpret_cast<const uint2*>(vp + 16);
      o[n] = mfma16(av.v, bp.v, o[n]);
    }
  }
}

struct KVb { uint4 k0, k1, v0, v1; };
struct KVf { float4 k0, k1, k2, k3, v0, v1, v2, v3; };
__device__ __forceinline__ void kv_issue_b(uint4& rk0, uint4& rk1, uint4& rv0, uint4& rv1, const u16* ks, const u16* vs, size_t stride, int tid) {
  const int row = tid >> 2, part = (tid & 3) * 16;
  const u16* s = ks + (size_t)row * stride + part;
  rk0 = *reinterpret_cast<const uint4*>(s);
  rk1 = *reinterpret_cast<const uint4*>(s + 8);
  const int dc = tid >> 5, kp = tid & 31;
  rv0 = *reinterpret_cast<const uint4*>(vs + (size_t)(2 * kp) * stride + dc * 8);
  rv1 = *reinterpret_cast<const uint4*>(vs + (size_t)(2 * kp + 1) * stride + dc * 8);
}
__device__ __forceinline__ void kv_commit_b(const uint4& rk0, const uint4& rk1, const uint4& rv0, const uint4& rv1, u16* Ksh, u16* Vt, int tid) {
  const int row = tid >> 2, part = (tid & 3) * 16;
  *reinterpret_cast<uint4*>(Ksh + row * 72 + part) = rk0;
  *reinterpret_cast<uint4*>(Ksh + row * 72 + part + 8) = rk1;
  const int dc = tid >> 5, kp = tid & 31;
  unsigned av[4] = {rv0.x, rv0.y, rv0.z, rv0.w}, bv[4] = {rv1.x, rv1.y, rv1.z, rv1.w};
#pragma unroll
  for (int i = 0; i < 4; ++i) {
    unsigned lo = (av[i] & 0xffffu) | (bv[i] << 16);
    unsigned hi = (av[i] >> 16) | (bv[i] & 0xffff0000u);
    *reinterpret_cast<unsigned*>(Vt + (dc * 8 + 2 * i) * 72 + 2 * kp) = lo;
    *reinterpret_cast<unsigned*>(Vt + (dc * 8 + 2 * i + 1) * 72 + 2 * kp) = hi;
  }
}
__device__ __forceinline__ void kv_issue_f(float4& fk0, float4& fk1, float4& fk2, float4& fk3, float4& fv0, float4& fv1, float4& fv2, float4& fv3, const float* ks, const float* vs, size_t stride, int tid) {
  const int row = tid >> 2, part = (tid & 3) * 16;
  const float* s = ks + (size_t)row * stride + part;
  fk0 = *reinterpret_cast<const float4*>(s);
  fk1 = *reinterpret_cast<const float4*>(s + 4);
  fk2 = *reinterpret_cast<const float4*>(s + 8);
  fk3 = *reinterpret_cast<const float4*>(s + 12);
  const int dc = tid >> 5, kp = tid & 31;
  const float* s0 = vs + (size_t)(2 * kp) * stride + dc * 8;
  const float* s1 = vs + (size_t)(2 * kp + 1) * stride + dc * 8;
  fv0 = *reinterpret_cast<const float4*>(s0);
  fv1 = *reinterpret_cast<const float4*>(s0 + 4);
  fv2 = *reinterpret_cast<const float4*>(s1);
  fv3 = *reinterpret_cast<const float4*>(s1 + 4);
}
__device__ __forceinline__ void kv_commit_f(const float4& fk0, const float4& fk1, const float4& fk2, const float4& fk3, const float4& fv0, const float4& fv1, const float4& fv2, const float4& fv3, u16* Ksh, u16* Vt, int tid) {
  const int row = tid >> 2, part = (tid & 3) * 16;
  uint4 o0, o1;
  o0.x = pack2(fk0.x, fk0.y); o0.y = pack2(fk0.z, fk0.w); o0.z = pack2(fk1.x, fk1.y); o0.w = pack2(fk1.z, fk1.w);
  o1.x = pack2(fk2.x, fk2.y); o1.y = pack2(fk2.z, fk2.w); o1.z = pack2(fk3.x, fk3.y); o1.w = pack2(fk3.z, fk3.w);
  *reinterpret_cast<uint4*>(Ksh + row * 72 + part) = o0;
  *reinterpret_cast<uint4*>(Ksh + row * 72 + part + 8) = o1;
  const int dc = tid >> 5, kp = tid & 31;
  float av[8] = {fv0.x, fv0.y, fv0.z, fv0.w, fv1.x, fv1.y, fv1.z, fv1.w};
  float bv[8] = {fv2.x, fv2.y, fv2.z, fv2.w, fv3.x, fv3.y, fv3.z, fv3.w};
#pragma unroll
  for (int i = 0; i < 8; ++i) *reinterpret_cast<unsigned*>(Vt + (dc * 8 + i) * 72 + 2 * kp) = pack2(av[i], bv[i]);
}

template <int KIND>
__device__ void attn_item(const Params& p, int l, int it, unsigned char* smem) {
  u16* Ksh = (u16*)smem;
  u16* Vt = Ksh + 64 * 72;
  float* rpbs = (float*)(Vt + 64 * 72);
  const int tid = otid(), w = tid >> 6, lane = tid & 63, r16 = lane & 15, quad = lane >> 4;
  int b, h, qt, Tq0;
  if (KIND < 2) { b = it >> 3; h = (it >> 1) & 3; qt = it & 1; Tq0 = b * 256 + qt * 128; }
  else { b = it >> 6; h = (it >> 4) & 3; qt = it & 15; Tq0 = NCTX + b * 2048 + qt * 128; }
  const bool isA = (KIND == 0 || KIND == 2);
  const int qcol = isA ? 0 : 768, gcol = isA ? 512 : 1536, mixcol = isA ? 0 : 256;
  const int kv = h >> 1;
  int qoff[2];
  if (KIND == 3) { qoff[0] = (w >> 1) * 64 + (w & 1) * 32; qoff[1] = qoff[0] + 16; }
  else { qoff[0] = w * 32; qoff[1] = w * 32 + 16; }
  bf16x8 aq[2][2];
  uint2 gpre[2][4];
#pragma unroll
  for (int g = 0; g < 2; ++g) {
    const size_t rowo = (size_t)(Tq0 + qoff[g] + r16) * 4096;
    const u16* qp = p.proj + rowo + qcol + h * 64 + quad * 8;
    aq[g][0] = ld8(qp);
    aq[g][1] = ld8(qp + 32);
    const u16* gp = p.proj + rowo + gcol + h * 64 + quad * 4;
#pragma unroll
    for (int n = 0; n < 4; ++n) gpre[g][n] = *reinterpret_cast<const uint2*>(gp + n * 16);
  }
  f32x4 o[2][4];
  float m[2] = {-1e30f, -1e30f}, ls[2] = {0.f, 0.f};
#pragma unroll
  for (int g = 0; g < 2; ++g)
#pragma unroll
    for (int n = 0; n < 4; ++n) o[g][n] = (f32x4){0.f, 0.f, 0.f, 0.f};
  auto nomask = [](int, float s) { return s; };

  int nloc, loc0, ktlo = 0, R0 = 0;
  const int kcol = isA ? 256 + kv * 64 : 1024 + h * 64;
  const int vcol = isA ? 384 + kv * 64 : 1280 + h * 64;
  if (KIND < 2) { nloc = 4; loc0 = b * 256; }
  else if (KIND == 2) {
    ktlo = 2 * qt - 2; if (ktlo < 0) ktlo = 0;
    int kthi = 2 * qt + 3; if (kthi > 31) kthi = 31;
    nloc = kthi - ktlo + 1;
    loc0 = NCTX + b * 2048 + ktlo * 64;
  } else {
    const int r0 = 2 * qt;
    R0 = r0 - 4; R0 = R0 < 0 ? 0 : (R0 > 24 ? 24 : R0);
    int R1 = r0 + 1 - 4; R1 = R1 < 0 ? 0 : (R1 > 24 ? 24 : R1);
    nloc = R1 + 8 - R0;
    loc0 = NCTX + b * 2048 + R0 * 64;
  }
  const int ntot = nloc + (KIND >= 2 ? 4 : 0);
  const u16* ck = nullptr; const u16* cv = nullptr; int cstride = 0;
  if (KIND == 2) { const size_t ro = (size_t)(b * 256) * 128 + kv * 64; ck = p.cbak + ro; cv = p.cbav + ro; cstride = 128; }
  if (KIND == 3) { const size_t ro = (size_t)(b * 256) * 256 + h * 64; ck = p.cbbk + ro; cv = p.cbbv + ro; cstride = 256; }
  int kbeg[2] = {0, 0};
  int myrow = 0, myR0 = 0;
  if (KIND == 3) {
    myrow = 2 * qt + (w >> 1);
    myR0 = myrow - 4; myR0 = myR0 < 0 ? 0 : (myR0 > 24 ? 24 : myR0);
#pragma unroll
    for (int g = 0; g < 2; ++g) {
      const int cb = (w & 1) * 2 + g;
      int kb = 16 * cb - 8; kb = kb < 0 ? 0 : (kb > 32 ? 32 : kb);
      kbeg[g] = kb;
    }
    __syncthreads();
    for (int i = tid; i < 15 * 31; i += 256) rpbs[i] = p.rpb[(size_t)((l * 4 + h) * 15) * 31 + i] * LOG2E;
  }
  uint4 ak0, ak1, av0, av1, bk0, bk1, bv0, bv1;
  auto issue = [&](int vt, uint4& k0, uint4& k1, uint4& v0, uint4& v1) {
    if (vt < nloc) {
      const u16* base = p.proj + (size_t)(loc0 + vt * 64) * 4096;
      kv_issue_b(k0, k1, v0, v1, base + kcol, base + vcol, 4096, tid);
    } else {
      const size_t ro = (size_t)((vt - nloc) * 64) * cstride;
      kv_issue_b(k0, k1, v0, v1, ck + ro, cv + ro, (size_t)cstride, tid);
    }
  };
  auto do_step = [&](int vt) {
#pragma unroll
    for (int g = 0; g < 2; ++g) {
      if (vt >= nloc || KIND < 2) {
        attn_step<4>(Ksh, Vt, 0, aq[g], o[g], m[g], ls[g], nomask, r16, quad);
      } else if (KIND == 2) {
        const int kpos0 = (ktlo + vt) * 64 - qt * 128;
        const int qa = qoff[g];
        const bool skip = (qa - (kpos0 + 63) > 128) || (qa + 15 - kpos0 < -128);
        if (!skip) {
          const int qrel = qa + r16 - kpos0;
          auto mk = [qrel](int key, float s) {
            int d = qrel - key;
            return (d <= 128 && d >= -128) ? s : -1e30f;
          };
          attn_step<4>(Ksh, Vt, 0, aq[g], o[g], m[g], ls[g], mk, r16, quad);
        }
      } else {
        const int kr = R0 + vt;
        if (kr >= myR0 && kr < myR0 + 8) {
          const int qc = ((w & 1) * 2 + g) * 16 + r16;
          int qws = qc - 8; qws = qws < 0 ? 0 : (qws > 48 ? 48 : qws);
          const float* rbp = rpbs + (kr - myrow + 7) * 31 + 15 - qc;
          auto mk = [qws, rbp](int key, float s) {
            bool ok = (key >= qws) && (key < qws + 16);
            return ok ? (s + rbp[ok ? key : qws]) : -1e30f;
          };
          attn_step<2>(Ksh, Vt, kbeg[g], aq[g], o[g], m[g], ls[g], mk, r16, quad);
        }
      }
    }
  };
  issue(0, ak0, ak1, av0, av1);
  if (ntot > 1) issue(1, bk0, bk1, bv0, bv1);
#pragma unroll 1
  for (int vt = 0; vt < ntot; vt += 2) {
    __syncthreads();
    kv_commit_b(ak0, ak1, av0, av1, Ksh, Vt, tid);
    __syncthreads();
    if (vt + 2 < ntot) issue(vt + 2, ak0, ak1, av0, av1);
    do_step(vt);
    if (vt + 1 < ntot) {
      __syncthreads();
      kv_commit_b(bk0, bk1, bv0, bv1, Ksh, Vt, tid);
      __syncthreads();
      if (vt + 3 < ntot) issue(vt + 3, bk0, bk1, bv0, bv1);
      do_step(vt + 1);
    }
  }
#pragma unroll
  for (int g = 0; g < 2; ++g) {
    float tot = ls[g] + __shfl_xor(ls[g], 16);
    tot += __shfl_xor(tot, 32);
    float sc = 1.f;
    if (isA) {
      const float sk = p.sink[l * 4 + h] * LOG2E;
      const float mn = fmaxf(m[g], sk);
      const float al = fexp2(m[g] - mn);
      tot = tot * al + fexp2(sk - mn);
      sc = al;
    }
    const float inv = sc / tot;
    const int T = Tq0 + qoff[g] + r16;
#pragma unroll
    for (int n = 0; n < 4; ++n) {
      const int dv = n * 16 + quad * 4;
      const uint2 gg = gpre[g][n];
      uint2 ov;
      ov.x = pack2(o[g][n][0] * inv * silu_f(bflo(gg.x)), o[g][n][1] * inv * silu_f(bfhi(gg.x)));
      ov.y = pack2(o[g][n][2] * inv * silu_f(bflo(gg.y)), o[g][n][3] * inv * silu_f(bfhi(gg.y)));
      *reinterpret_cast<uint2*>(p.hbuf + (size_t)T * HS + mixcol + h * 64 + dv) = ov;
    }
  }
  __syncthreads();
}

__device__ void csum_item(const Params& p, int l, int it, unsigned char* smem) {
  u16* Ktf = (u16*)smem;
  u16* Ktb = Ktf + 64 * 72;
  u16* Vt = Ktb + 64 * 72;
  const int tid = otid(), w = tid >> 6, lane = tid & 63, r16 = lane & 15, quad = lane >> 4;
  const int c = it >> 2, h = it & 3, T0 = c * 64;
  const float lgf = ret_lg2(p, l, 0, h), lgb = ret_lg2(p, l, 1, h);
  __syncthreads();
  {
    const int dc = tid >> 5, kp = tid & 31, j0 = 2 * kp, j1 = j0 + 1;
    const u16* kb = p.proj + (size_t)(T0 + j0) * 4096 + 2048 + h * 64 + dc * 8;
    uint4 a = *reinterpret_cast<const uint4*>(kb);
    uint4 b = *reinterpret_cast<const uint4*>(kb + 4096);
    unsigned av[4] = {a.x, a.y, a.z, a.w}, bv[4] = {b.x, b.y, b.z, b.w};
    const float wf0 = 0.125f * fexp2(lgf * (float)(63 - j0)), wf1 = 0.125f * fexp2(lgf * (float)(63 - j1));
    const float wb0 = 0.125f * fexp2(lgb * (float)j0), wb1 = 0.125f * fexp2(lgb * (float)j1);
#pragma unroll
    for (int i = 0; i < 4; ++i) {
      float k0l = bflo(av[i]), k0h = bfhi(av[i]), k1l = bflo(bv[i]), k1h = bfhi(bv[i]);
      *reinterpret_cast<unsigned*>(Ktf + (dc * 8 + 2 * i) * 72 + j0) = pack2(k0l * wf0, k1l * wf1);
      *reinterpret_cast<unsigned*>(Ktf + (dc * 8 + 2 * i + 1) * 72 + j0) = pack2(k0h * wf0, k1h * wf1);
      *reinterpret_cast<unsigned*>(Ktb + (dc * 8 + 2 * i) * 72 + j0) = pack2(k0l * wb0, k1l * wb1);
      *reinterpret_cast<unsigned*>(Ktb + (dc * 8 + 2 * i + 1) * 72 + j0) = pack2(k0h * wb0, k1h * wb1);
    }
  }
  ld_tr_bf16(Vt, p.proj + (size_t)T0 * 4096 + 2304 + h * 64, 4096);
  __syncthreads();
#pragma unroll
  for (int dir = 0; dir < 2; ++dir) {
    const u16* Kt = dir ? Ktb : Ktf;
    f32x4 acc[4];
#pragma unroll
    for (int mt = 0; mt < 4; ++mt) acc[mt] = (f32x4){0.f, 0.f, 0.f, 0.f};
#pragma unroll
    for (int ks = 0; ks < 2; ++ks) {
      bf16x8 bv = ld8(Vt + (w * 16 + r16) * 72 + ks * 32 + quad * 8);
#pragma unroll
      for (int mt = 0; mt < 4; ++mt) acc[mt] = mfma16(ld8(Kt + (mt * 16 + r16) * 72 + ks * 32 + quad * 8), bv, acc[mt]);
    }
    u16* U = p.uc + (size_t)((c * 4 + h) * 2 + dir) * 4096 + (w * 16 + r16) * 64;
#pragma unroll
    for (int mt = 0; mt < 4; ++mt) {
      uint2 o;
      o.x = pack2(acc[mt][0], acc[mt][1]);
      o.y = pack2(acc[mt][2], acc[mt][3]);
      *reinterpret_cast<uint2*>(U + mt * 16 + quad * 4) = o;
    }
  }
  __syncthreads();
}

__device__ __forceinline__ void hgrn_gates(const uint4 a, const uint4 b, int dir, const float* lbs, float* Bc, float* kkf, u16* kkb, float* segtot) {
  const int tid = otid();
  {
    const int j = tid >> 2, part = (tid & 3) * 16;
    unsigned zz[8] = {a.x, a.y, a.z, a.w, b.x, b.y, b.z, b.w};
    float lfv[16], kfv[16];
#pragma unroll
    for (int i = 0; i < 16; ++i) {
      float z = (i & 1) ? bfhi(zz[i >> 1]) : bflo(zz[i >> 1]);
      float lb = fmaxf(lbs[dir * 64 + part + i], 1e-30f);
      float sneg = __builtin_amdgcn_rcpf(1.f + __expf(z));
      float spos = __builtin_amdgcn_rcpf(1.f + __expf(-z));
      kfv[i] = (1.f - lb) * sneg;
      float f = lb + (1.f - lb) * spos;
      lfv[i] = __log2f(fmaxf(f, 1e-30f));
    }
#pragma unroll
    for (int i = 0; i < 4; ++i) {
      *reinterpret_cast<float4*>(Bc + j * 68 + part + 4 * i) = make_float4(lfv[4 * i], lfv[4 * i + 1], lfv[4 * i + 2], lfv[4 * i + 3]);
      if (kkf) *reinterpret_cast<float4*>(kkf + j * 68 + part + 4 * i) = make_float4(kfv[4 * i], kfv[4 * i + 1], kfv[4 * i + 2], kfv[4 * i + 3]);
    }
    if (kkb) {
      uint4 o0, o1;
      o0.x = pack2(kfv[0], kfv[1]); o0.y = pack2(kfv[2], kfv[3]); o0.z = pack2(kfv[4], kfv[5]); o0.w = pack2(kfv[6], kfv[7]);
      o1.x = pack2(kfv[8], kfv[9]); o1.y = pack2(kfv[10], kfv[11]); o1.z = pack2(kfv[12], kfv[13]); o1.w = pack2(kfv[14], kfv[15]);
      *reinterpret_cast<uint4*>(kkb + j * 72 + part) = o0;
      *reinterpret_cast<uint4*>(kkb + j * 72 + part + 8) = o1;
    }
  }
  __syncthreads();
  const int ch = tid & 63, seg = tid >> 6;
  float v[16];
#pragma unroll
  for (int jj = 0; jj < 16; ++jj) v[jj] = Bc[(seg * 16 + jj) * 68 + ch];
  float tot;
  if (dir == 0) {
#pragma unroll
    for (int jj = 1; jj < 16; ++jj) v[jj] += v[jj - 1];
    tot = v[15];
  } else {
#pragma unroll
    for (int jj = 14; jj >= 0; --jj) v[jj] += v[jj + 1];
    tot = v[0];
  }
  segtot[seg * 64 + ch] = tot;
  __syncthreads();
  float off = 0.f;
#pragma unroll
  for (int s2 = 0; s2 < 4; ++s2) {
    const float t2 = segtot[s2 * 64 + ch];
    const bool use = dir ? (s2 > seg) : (s2 < seg);
    off += use ? t2 : 0.f;
  }
#pragma unroll
  for (int jj = 0; jj < 16; ++jj) Bc[(seg * 16 + jj) * 68 + ch] = v[jj] + off;
  __syncthreads();
}

__device__ void dsum_item(const Params& p, int l, int it, unsigned char* smem) {
  float* Bc = (float*)smem;
  float* kk = Bc + 64 * 68;
  u16* Kt = (u16*)(kk + 64 * 68);
  u16* Vt = Kt + 64 * 72;
  float* lbs = (float*)(Vt + 64 * 72);
  const int tid = otid(), w = tid >> 6, lane = tid & 63, r16 = lane & 15, quad = lane >> 4;
  const int c = it >> 2, h = it & 3, T0 = c * 64;
  __syncthreads();
  uint4 zf0, zf1, zb0, zb1;
  {
    const u16* zp = p.proj + (size_t)(T0 + (tid >> 2)) * 4096 + 3072 + h * 64 + (tid & 3) * 16;
    zf0 = *reinterpret_cast<const uint4*>(zp); zf1 = *reinterpret_cast<const uint4*>(zp + 8);
    zb0 = *reinterpret_cast<const uint4*>(zp + 256); zb1 = *reinterpret_cast<const uint4*>(zp + 264);
  }
  if (tid < 128) lbs[tid] = hgrn_lb(p, l, tid >> 6, h * 64 + (tid & 63));
  ld_tr_bf16(Vt, p.proj + (size_t)T0 * 4096 + 3584 + h * 64, 4096);
  __syncthreads();
#pragma unroll
  for (int dir = 0; dir < 2; ++dir) {
    hgrn_gates(dir ? zb0 : zf0, dir ? zb1 : zf1, dir, lbs, Bc, kk, nullptr, lbs + 128);
    const int lastj = dir ? 0 : 63;
    {
      const int j = tid >> 2, part = (tid & 3) * 16;
#pragma unroll
      for (int i4 = 0; i4 < 4; ++i4) {
        const int ch = part + 4 * i4;
        float4 kv4 = *reinterpret_cast<const float4*>(kk + j * 68 + ch);
        float4 bl = *reinterpret_cast<const float4*>(Bc + lastj * 68 + ch);
        float4 bj = *reinterpret_cast<const float4*>(Bc + j * 68 + ch);
        Kt[(ch + 0) * 72 + j] = f2bf(kv4.x * fexp2(bl.x - bj.x));
        Kt[(ch + 1) * 72 + j] = f2bf(kv4.y * fexp2(bl.y - bj.y));
        Kt[(ch + 2) * 72 + j] = f2bf(kv4.z * fexp2(bl.z - bj.z));
        Kt[(ch + 3) * 72 + j] = f2bf(kv4.w * fexp2(bl.w - bj.w));
      }
    }
    if (tid < 64) p.dg[(size_t)((c * 4 + h) * 2 + dir) * 64 + tid] = fexp2(Bc[lastj * 68 + tid]);
    __syncthreads();
    f32x4 acc[4];
#pragma unroll
    for (int mt = 0; mt < 4; ++mt) acc[mt] = (f32x4){0.f, 0.f, 0.f, 0.f};
#pragma unroll
    for (int ks = 0; ks < 2; ++ks) {
      bf16x8 bv = ld8(Vt + (w * 16 + r16) * 72 + ks * 32 + quad * 8);
#pragma unroll
      for (int mt = 0; mt < 4; ++mt) acc[mt] = mfma16(ld8(Kt + (mt * 16 + r16) * 72 + ks * 32 + quad * 8), bv, acc[mt]);
    }
    u16* U = p.ud + (size_t)((c * 4 + h) * 2 + dir) * 4096 + (w * 16 + r16) * 64;
#pragma unroll
    for (int mt = 0; mt < 4; ++mt) {
      uint2 o;
      o.x = pack2(acc[mt][0], acc[mt][1]);
      o.y = pack2(acc[mt][2], acc[mt][3]);
      *reinterpret_cast<uint2*>(U + mt * 16 + quad * 4) = o;
    }
    __syncthreads();
  }
}

template <int ISD, int NB>
__device__ __forceinline__ void scan_batch(u16* U, const float* dgp, int c0, int cstep, int h, int dir, int e, int dk, float dec,
                                           float& S0, float& S1, float& S2, float& S3) {
  unsigned u[NB], w2[NB];
  float2 d[NB];
#pragma unroll
  for (int i = 0; i < NB; ++i) {
    const int c = c0 + i * cstep;
    const size_t blk = (size_t)((c * 4 + h) * 2 + dir);
    u[i] = *reinterpret_cast<const unsigned*>(U + blk * 4096 + e);
    w2[i] = *reinterpret_cast<const unsigned*>(U + blk * 4096 + e + 2048);
    if (ISD) d[i] = *reinterpret_cast<const float2*>(dgp + blk * 64 + dk);
  }
#pragma unroll
  for (int i = 0; i < NB; ++i) {
    const int c = c0 + i * cstep;
    const size_t blk = (size_t)((c * 4 + h) * 2 + dir);
    *reinterpret_cast<unsigned*>(U + blk * 4096 + e) = pack2(S0, S1);
    *reinterpret_cast<unsigned*>(U + blk * 4096 + e + 2048) = pack2(S2, S3);
    const float d0 = ISD ? d[i].x : dec, d1 = ISD ? d[i].y : dec;
    S0 = S0 * d0 + bflo(u[i]);
    S1 = S1 * d1 + bfhi(u[i]);
    S2 = S2 * d0 + bflo(w2[i]);
    S3 = S3 * d1 + bfhi(w2[i]);
  }
}
template <int ISD>
__device__ void scan_item(const Params& p, int l, int it) {
  const int tid = otid();
  const int part = it & 3, dir = (it >> 2) & 1, h = (it >> 3) & 3, sidx = it >> 5;
  const int e = (part * 256 + tid) * 2, dv = e >> 6, dk = e & 63;
  const bool ctx = sidx < 16;
  const int nch = ctx ? 4 : 32;
  const int cb = ctx ? sidx * 4 : 64 + (sidx - 16) * 32;
  u16* U = ISD ? p.ud : p.uc;
  float dec = 0.f;
  if (!ISD) dec = fexp2(64.f * ret_lg2(p, l, dir, h));
  float S0 = 0.f, S1 = 0.f, S2 = 0.f, S3 = 0.f;
  if (!ctx) {
    const float* st = (ISD ? p.st_hgrn : p.st_ret) + (size_t)((((sidx - 16) * 4 + l) * 2 + dir) * 4 + h) * 4096;
    S0 = st[dk * 64 + dv];
    S1 = st[(dk + 1) * 64 + dv];
    S2 = st[dk * 64 + dv + 32];
    S3 = st[(dk + 1) * 64 + dv + 32];
  }
  const int cstart = dir ? (cb + nch - 1) : cb, cstep = dir ? -1 : 1;
  if (ctx) {
    scan_batch<ISD, 4>(U, p.dg, cstart, cstep, h, dir, e, dk, dec, S0, S1, S2, S3);
    float* os = p.out + (ISD ? OUT_SH : OUT_SR) + (size_t)(((sidx * 4 + l) * 2 + dir) * 4 + h) * 4096;
    os[dk * 64 + dv] = S0;
    os[(dk + 1) * 64 + dv] = S1;
    os[dk * 64 + dv + 32] = S2;
    os[(dk + 1) * 64 + dv + 32] = S3;
  } else {
    scan_batch<ISD, 16>(U, p.dg, cstart, cstep, h, dir, e, dk, dec, S0, S1, S2, S3);
    scan_batch<ISD, 16>(U, p.dg, cstart + 16 * cstep, cstep, h, dir, e, dk, dec, S0, S1, S2, S3);
  }
}

__device__ __forceinline__ void load_gate_rows(const Params& p, int Trow0, int gcol, int lane, uint4& g0, uint4& g1) {
  const int row = lane >> 2, c0 = (lane & 3) * 16;
  const u16* gp = p.proj + (size_t)(Trow0 + row) * 4096 + gcol + c0;
  g0 = *reinterpret_cast<const uint4*>(gp);
  g1 = *reinterpret_cast<const uint4*>(gp + 8);
}
__device__ __forceinline__ void store_rows_gated(const Params& p, float* stg  , const float (&val)[4][4],
                                                 int Trow0, const uint4 g0, const uint4 g1, int mcol, int lane) {
  const int r16 = lane & 15, quad = lane >> 4;
#pragma unroll
  for (int n = 0; n < 4; ++n)
#pragma unroll
    for (int j = 0; j < 4; ++j) stg[(quad * 4 + j) * 68 + n * 16 + r16] = val[n][j];
  wave_lds_sync();
  const int row = lane >> 2, c0 = (lane & 3) * 16;
  const int T = Trow0 + row;
  unsigned gw[8] = {g0.x, g0.y, g0.z, g0.w, g1.x, g1.y, g1.z, g1.w};
  unsigned ow[8];
#pragma unroll
  for (int i = 0; i < 4; ++i) {
    float4 v = *reinterpret_cast<const float4*>(stg + row * 68 + c0 + 4 * i);
    ow[2 * i] = pack2(v.x * silu_f(bflo(gw[2 * i])), v.y * silu_f(bfhi(gw[2 * i])));
    ow[2 * i + 1] = pack2(v.z * silu_f(bflo(gw[2 * i + 1])), v.w * silu_f(bfhi(gw[2 * i + 1])));
  }
  u16* op = p.hbuf + (size_t)T * HS + mcol + c0;
  *reinterpret_cast<uint4*>(op) = make_uint4(ow[0], ow[1], ow[2], ow[3]);
  *reinterpret_cast<uint4*>(op + 8) = make_uint4(ow[4], ow[5], ow[6], ow[7]);
}

__device__ void cout_item(const Params& p, int l, int it, unsigned char* smem) {
  u16* Qs = (u16*)smem;
  u16* Ks = Qs + 64 * 72;
  u16* Vt = Ks + 64 * 72;
  u16* SfT = Vt + 64 * 72;
  u16* SbT = SfT + 64 * 72;
  u16* Ps = SbT + 64 * 72;
  const int tid = otid(), w = tid >> 6, lane = tid & 63, r16 = lane & 15, quad = lane >> 4;
  const int c = it >> 2, h = it & 3, T0 = c * 64;
  const float lgf = ret_lg2(p, l, 0, h), lgb = ret_lg2(p, l, 1, h);
  uint4 gt0, gt1;
  load_gate_rows(p, T0 + w * 16, 2560 + h * 64, lane, gt0, gt1);
  __syncthreads();
  const u16* base = p.proj + (size_t)T0 * 4096;
  ld_rows_bf16(Qs, base + 1792 + h * 64, 4096);
  ld_rows_bf16(Ks, base + 2048 + h * 64, 4096);
  ld_tr_bf16(Vt, base + 2304 + h * 64, 4096);
  ld_rows_bf16(SfT, p.uc + (size_t)((c * 4 + h) * 2 + 0) * 4096, 64);
  ld_rows_bf16(SbT, p.uc + (size_t)((c * 4 + h) * 2 + 1) * 4096, 64);
  __syncthreads();
  const int i0 = w * 16;
  bf16x8 aq[2];
  aq[0] = ld8(Qs + (i0 + r16) * 72 + quad * 8);
  aq[1] = ld8(Qs + (i0 + r16) * 72 + 32 + quad * 8);
  f32x4 s[4];
#pragma unroll
  for (int nt = 0; nt < 4; ++nt) {
    s[nt] = (f32x4){0.f, 0.f, 0.f, 0.f};
#pragma unroll
    for (int ks = 0; ks < 2; ++ks) s[nt] = mfma16(aq[ks], ld8(Ks + (nt * 16 + r16) * 72 + ks * 32 + quad * 8), s[nt]);
  }
#pragma unroll
  for (int nt = 0; nt < 4; ++nt)
#pragma unroll
    for (int j = 0; j < 4; ++j) {
      const int i = i0 + quad * 4 + j, jj = nt * 16 + r16, d = i - jj;
      float wgt = (d > 0) ? fexp2(lgf * (float)d) : ((d < 0) ? fexp2(lgb * (float)(-d)) : 2.f);
      Ps[i * 72 + jj] = f2bf(s[nt][j] * 0.125f * wgt);
    }
  wave_lds_sync();
  f32x4 o[4], xf[4], xb[4];
#pragma unroll
  for (int n = 0; n < 4; ++n) { o[n] = (f32x4){0.f, 0.f, 0.f, 0.f}; xf[n] = o[n]; xb[n] = o[n]; }
#pragma unroll
  for (int ks = 0; ks < 2; ++ks) {
    bf16x8 ap = ld8(Ps + (i0 + r16) * 72 + ks * 32 + quad * 8);
#pragma unroll
    for (int n = 0; n < 4; ++n) {
      o[n] = mfma16(ap, ld8(Vt + (n * 16 + r16) * 72 + ks * 32 + quad * 8), o[n]);
      xf[n] = mfma16(aq[ks], ld8(SfT + (n * 16 + r16) * 72 + ks * 32 + quad * 8), xf[n]);
      xb[n] = mfma16(aq[ks], ld8(SbT + (n * 16 + r16) * 72 + ks * 32 + quad * 8), xb[n]);
    }
  }
  float val[4][4];
#pragma unroll
  for (int j = 0; j < 4; ++j) {
    const int i = i0 + quad * 4 + j;
    const float qf = fexp2(lgf * (float)(i + 1)), qb = fexp2(lgb * (float)(64 - i));
    float t[4], sum = 0.f;
#pragma unroll
    for (int n = 0; n < 4; ++n) { t[n] = o[n][j] + qf * xf[n][j] + qb * xb[n][j]; sum += t[n]; }
    const float mu = gsum16(sum) * (1.f / 64.f);
    float vs = 0.f;
#pragma unroll
    for (int n = 0; n < 4; ++n) { t[n] -= mu; vs += t[n] * t[n]; }
    const float rstd = rsqrtf(gsum16(vs) * (1.f / 64.f) + 1e-6f);
#pragma unroll
    for (int n = 0; n < 4; ++n) val[n][j] = t[n] * rstd;
  }
  __syncthreads();
  store_rows_gated(p, (float*)smem + w * (16 * 68), val, T0 + i0, gt0, gt1, 512 + h * 64, lane);
  __syncthreads();
}

__device__ void dout_item(const Params& p, int l, int it, unsigned char* smem) {
  u16* qs = (u16*)smem;
  u16* Vt = qs + 64 * 72;
  u16* kkb = Vt + 64 * 72;
  u16* Kt = kkb + 64 * 72;
  u16* ST = Kt + 64 * 72;
  u16* Ps = ST + 64 * 72;
  float* Bc = (float*)(Ps + 64 * 72);
  float* Rref = Bc + 64 * 68;
  float* lbs = Rref + 256;
  const int tid = otid(), w = tid >> 6, lane = tid & 63, r16 = lane & 15, quad = lane >> 4;
  const int c = it >> 2, h = it & 3, T0 = c * 64;
  uint4 gt0, gt1;
  load_gate_rows(p, T0 + w * 16, 3840 + h * 64, lane, gt0, gt1);
  uint4 zf0, zf1, zb0, zb1, sf0, sf1, sb0, sb1;
  {
    const int row = tid >> 2, part = (tid & 3) * 16;
    const u16* zp = p.proj + (size_t)(T0 + row) * 4096 + 3072 + h * 64 + part;
    zf0 = *reinterpret_cast<const uint4*>(zp); zf1 = *reinterpret_cast<const uint4*>(zp + 8);
    zb0 = *reinterpret_cast<const uint4*>(zp + 256); zb1 = *reinterpret_cast<const uint4*>(zp + 264);
    const u16* sp = p.ud + (size_t)((c * 4 + h) * 2) * 4096 + row * 64 + part;
    sf0 = *reinterpret_cast<const uint4*>(sp); sf1 = *reinterpret_cast<const uint4*>(sp + 8);
    sb0 = *reinterpret_cast<const uint4*>(sp + 4096); sb1 = *reinterpret_cast<const uint4*>(sp + 4096 + 8);
  }
  __syncthreads();
  if (tid < 128) lbs[tid] = hgrn_lb(p, l, tid >> 6, h * 64 + (tid & 63));
  {
    const int row = tid >> 2, part = (tid & 3) * 16;
    const u16* s = p.proj + (size_t)(T0 + row) * 4096 + 2816 + h * 64 + part;
    uint4 a = *reinterpret_cast<const uint4*>(s), b = *reinterpret_cast<const uint4*>(s + 8);
    unsigned zz[8] = {a.x, a.y, a.z, a.w, b.x, b.y, b.z, b.w};
#pragma unroll
    for (int i = 0; i < 8; ++i) zz[i] = pack2(silu_f(bflo(zz[i])), silu_f(bfhi(zz[i])));
    uint4 o0 = {zz[0], zz[1], zz[2], zz[3]}, o1 = {zz[4], zz[5], zz[6], zz[7]};
    *reinterpret_cast<uint4*>(qs + row * 72 + part) = o0;
    *reinterpret_cast<uint4*>(qs + row * 72 + part + 8) = o1;
  }
  ld_tr_bf16(Vt, p.proj + (size_t)T0 * 4096 + 3584 + h * 64, 4096);
  f32x4 o[4];
#pragma unroll
  for (int n = 0; n < 4; ++n) o[n] = (f32x4){0.f, 0.f, 0.f, 0.f};
  const int I = w;
#pragma unroll
  for (int dir = 0; dir < 2; ++dir) {
    __syncthreads();
    {
      const int row = tid >> 2, part = (tid & 3) * 16;
      *reinterpret_cast<uint4*>(ST + row * 72 + part) = dir ? sb0 : sf0;
      *reinterpret_cast<uint4*>(ST + row * 72 + part + 8) = dir ? sb1 : sf1;
    }
    hgrn_gates(dir ? zb0 : zf0, dir ? zb1 : zf1, dir, lbs, Bc, nullptr, kkb, Rref);
    Rref[tid] = Bc[((tid >> 6) * 16 + (dir ? 0 : 15)) * 68 + (tid & 63)];
    __syncthreads();
    {
      const int j = tid >> 2, part = (tid & 3) * 16;
      unsigned ov[8];
      uint4 kk0 = *reinterpret_cast<const uint4*>(kkb + j * 72 + part), kk1 = *reinterpret_cast<const uint4*>(kkb + j * 72 + part + 8);
      unsigned kw[8] = {kk0.x, kk0.y, kk0.z, kk0.w, kk1.x, kk1.y, kk1.z, kk1.w};
#pragma unroll
      for (int i4 = 0; i4 < 4; ++i4) {
        float4 rr = *reinterpret_cast<const float4*>(Rref + (j >> 4) * 64 + part + 4 * i4);
        float4 bb = *reinterpret_cast<const float4*>(Bc + j * 68 + part + 4 * i4);
        ov[2 * i4] = pack2(bflo(kw[2 * i4]) * fexp2(rr.x - bb.x), bfhi(kw[2 * i4]) * fexp2(rr.y - bb.y));
        ov[2 * i4 + 1] = pack2(bflo(kw[2 * i4 + 1]) * fexp2(rr.z - bb.z), bfhi(kw[2 * i4 + 1]) * fexp2(rr.w - bb.w));
      }
      uint4 o0 = {ov[0], ov[1], ov[2], ov[3]}, o1 = {ov[4], ov[5], ov[6], ov[7]};
      *reinterpret_cast<uint4*>(Kt + j * 72 + part) = o0;
      *reinterpret_cast<uint4*>(Kt + j * 72 + part + 8) = o1;
    }
    __syncthreads();
    f32x4 sacc[4];
#pragma unroll
    for (int J = 0; J < 4; ++J) sacc[J] = (f32x4){0.f, 0.f, 0.f, 0.f};
    const int irow = 16 * I + r16;
#pragma unroll
    for (int J = 0; J < 4; ++J) {
      const bool act = dir ? (J > I) : (J < I);
      if (act) {
#pragma unroll
        for (int ks = 0; ks < 2; ++ks) {
          const int ch0 = ks * 32 + quad * 8;
          uint4 qv = *reinterpret_cast<const uint4*>(qs + irow * 72 + ch0);
          unsigned qq[4] = {qv.x, qv.y, qv.z, qv.w};
          float4 b0 = *reinterpret_cast<const float4*>(Bc + irow * 68 + ch0), b1 = *reinterpret_cast<const float4*>(Bc + irow * 68 + ch0 + 4);
          float4 r0 = *reinterpret_cast<const float4*>(Rref + J * 64 + ch0), r1 = *reinterpret_cast<const float4*>(Rref + J * 64 + ch0 + 4);
          union { unsigned u[4]; bf16x8 v; } a;
          a.u[0] = pack2(bflo(qq[0]) * fexp2(b0.x - r0.x), bfhi(qq[0]) * fexp2(b0.y - r0.y));
          a.u[1] = pack2(bflo(qq[1]) * fexp2(b0.z - r0.z), bfhi(qq[1]) * fexp2(b0.w - r0.w));
          a.u[2] = pack2(bflo(qq[2]) * fexp2(b1.x - r1.x), bfhi(qq[2]) * fexp2(b1.y - r1.y));
          a.u[3] = pack2(bflo(qq[3]) * fexp2(b1.z - r1.z), bfhi(qq[3]) * fexp2(b1.w - r1.w));
          sacc[J] = mfma16(a.v, ld8(Kt + (16 * J + r16) * 72 + ch0), sacc[J]);
        }
      }
    }
#pragma unroll
    for (int J = 0; J < 4; ++J)
#pragma unroll
      for (int j = 0; j < 4; ++j) Ps[(16 * I + quad * 4 + j) * 72 + 16 * J + r16] = f2bf(sacc[J][j]);
    {
      const int rbase = 16 * I;
#pragma unroll 3
      for (int itq = 0; itq < 9; ++itq) {
        const int qp = itq * 64 + lane;
        const bool valid = qp < 544;
        const int pp = valid ? (qp >> 2) : 0, cq = qp & 3;
        int a2 = (int)((sqrtf(8.f * (float)pp + 1.f) - 1.f) * 0.5f);
        if ((a2 + 1) * (a2 + 2) / 2 <= pp) ++a2;
        if (a2 * (a2 + 1) / 2 > pp) --a2;
        const int b2 = pp - a2 * (a2 + 1) / 2;
        const int i = rbase + (dir ? b2 : a2), key = rbase + (dir ? a2 : b2);
        float sum = 0.f;
#pragma unroll
        for (int c8 = 0; c8 < 2; ++c8) {
          const int ch0 = cq * 16 + c8 * 8;
          uint4 kq = *reinterpret_cast<const uint4*>(kkb + key * 72 + ch0);
          unsigned kq4[4] = {kq.x, kq.y, kq.z, kq.w};
          float4 bk0 = *reinterpret_cast<const float4*>(Bc + key * 68 + ch0);
          float4 bk1 = *reinterpret_cast<const float4*>(Bc + key * 68 + ch0 + 4);
          float bk[8] = {bk0.x, bk0.y, bk0.z, bk0.w, bk1.x, bk1.y, bk1.z, bk1.w};
          uint4 qv = *reinterpret_cast<const uint4*>(qs + i * 72 + ch0);
          unsigned qq[4] = {qv.x, qv.y, qv.z, qv.w};
          float4 bi0 = *reinterpret_cast<const float4*>(Bc + i * 68 + ch0);
          float4 bi1 = *reinterpret_cast<const float4*>(Bc + i * 68 + ch0 + 4);
          float bi[8] = {bi0.x, bi0.y, bi0.z, bi0.w, bi1.x, bi1.y, bi1.z, bi1.w};
#pragma unroll
          for (int e2 = 0; e2 < 4; ++e2) {
            float w0 = fexp2(fminf(bi[2 * e2] - bk[2 * e2], 0.f));
            float w1 = fexp2(fminf(bi[2 * e2 + 1] - bk[2 * e2 + 1], 0.f));
            sum += bflo(qq[e2]) * bflo(kq4[e2]) * w0 + bfhi(qq[e2]) * bfhi(kq4[e2]) * w1;
          }
        }
        sum += DPPF(sum, 0xB1);
        sum += DPPF(sum, 0x4E);
        if (valid && cq == 0) Ps[i * 72 + key] = f2bf(sum);
      }
    }
    wave_lds_sync();
#pragma unroll
    for (int ks = 0; ks < 2; ++ks) {
      const int ch0 = ks * 32 + quad * 8;
      bf16x8 ap = ld8(Ps + irow * 72 + ch0);
      uint4 qv = *reinterpret_cast<const uint4*>(qs + irow * 72 + ch0);
      unsigned qq[4] = {qv.x, qv.y, qv.z, qv.w};
      float4 b0 = *reinterpret_cast<const float4*>(Bc + irow * 68 + ch0), b1 = *reinterpret_cast<const float4*>(Bc + irow * 68 + ch0 + 4);
      union { unsigned u[4]; bf16x8 v; } a;
      a.u[0] = pack2(bflo(qq[0]) * fexp2(b0.x), bfhi(qq[0]) * fexp2(b0.y));
      a.u[1] = pack2(bflo(qq[1]) * fexp2(b0.z), bfhi(qq[1]) * fexp2(b0.w));
      a.u[2] = pack2(bflo(qq[2]) * fexp2(b1.x), bfhi(qq[2]) * fexp2(b1.y));
      a.u[3] = pack2(bflo(qq[3]) * fexp2(b1.z), bfhi(qq[3]) * fexp2(b1.w));
#pragma unroll
      for (int n = 0; n < 4; ++n) {
        o[n] = mfma16(ap, ld8(Vt + (n * 16 + r16) * 72 + ch0), o[n]);
        o[n] = mfma16(a.v, ld8(ST + (n * 16 + r16) * 72 + ch0), o[n]);
      }
    }
  }
  float val[4][4];
#pragma unroll
  for (int j = 0; j < 4; ++j) {
    float ss = 0.f;
#pragma unroll
    for (int n = 0; n < 4; ++n) ss += o[n][j] * o[n][j];
    const float rstd = rsqrtf(gsum16(ss) * (1.f / 64.f) + 1e-6f);
#pragma unroll
    for (int n = 0; n < 4; ++n) val[n][j] = o[n][j] * rstd;
  }
  __syncthreads();
  store_rows_gated(p, (float*)smem + w * (16 * 68), val, T0 + 16 * I, gt0, gt1, 768 + h * 64, lane);
  __syncthreads();
}

#define XB_TMO      128
#define XB_XCNT(j)  (256  + 64 * (j))
#define XB_XSUB(j)  (1280 + 64 * (j))
#define XB_XGEN(j)  (2304 + 64 * (j))
#define XB_TOP      3328
#define XB_TOPGEN   3392
#define XCD_BAR_WORDS 3456
#define XB_SPIN_CAP (1u << 18)
#define LAS __attribute__((address_space(3)))
__device__ __forceinline__ unsigned xb_ld(unsigned* p)              { return __hip_atomic_load(p, __ATOMIC_RELAXED, __HIP_MEMORY_SCOPE_AGENT); }
__device__ __forceinline__ unsigned xb_add(unsigned* p, unsigned v) { return __hip_atomic_fetch_add(p, v, __ATOMIC_RELAXED, __HIP_MEMORY_SCOPE_AGENT); }
__device__ __forceinline__ unsigned xb_xcc_id() { return (unsigned)__builtin_amdgcn_s_getreg((3 << 11) | 20) & 0xFu; }
#define XB_SPIN(cond, bar) do { unsigned _sp = 0; while (cond) { __builtin_amdgcn_s_sleep(1); \
    if ((++_sp & 255u) == 0u) { if (xb_ld(&(bar)[XB_TMO])) break; if (_sp > XB_SPIN_CAP) { atomicAdd(&(bar)[XB_TMO], 1u); break; } } } } while (0)
struct XcdBarrier { unsigned* bar; unsigned x; volatile LAS unsigned* st; };
__device__ __forceinline__ XcdBarrier xcd_barrier_post(unsigned* bar, volatile LAS unsigned* st) {
    XcdBarrier b; b.bar = bar; b.x = xb_xcc_id(); b.st = st;
    if (threadIdx.x == 0) (void)xb_add(&bar[XB_XCNT(b.x)], 1u);
    return b;
}
__device__ __forceinline__ void xcd_barrier_complete(unsigned* bar, unsigned x, unsigned& nloc, unsigned& nx) {
    const unsigned G = gridDim.x * gridDim.y * gridDim.z;
    unsigned sum, cnt, mine, sp = 0u;
    for (;;) {
        sum = 0u; cnt = 0u; mine = 0u;
#pragma unroll
        for (unsigned j = 0; j < 16; ++j) { const unsigned c = xb_ld(&bar[XB_XCNT(j)]); sum += c; cnt += (c > 0u) ? 1u : 0u; mine = (j == x) ? c : mine; }
        if (sum == G) break;
        __builtin_amdgcn_s_sleep(1);
        if ((++sp & 255u) == 0u) { if (xb_ld(&bar[XB_TMO])) break; if (sp > XB_SPIN_CAP) { atomicAdd(&bar[XB_TMO], 1u); break; } }
    }
    nloc = mine > 0u ? mine : 1u; nx = cnt > 0u ? cnt : 1u;
}
__device__ __forceinline__ void xcd_barrier(const XcdBarrier& b) {
    asm volatile("s_waitcnt vmcnt(0)" ::: "memory");
    __syncthreads();
    if (threadIdx.x == 0) {
        unsigned* bar = b.bar;
        __builtin_amdgcn_s_waitcnt(0);
        unsigned nloc = b.st[0], nx = b.st[1];
        if (nloc == 0u) { xcd_barrier_complete(bar, b.x, nloc, nx); b.st[0] = nloc; b.st[1] = nx; }
        const unsigned old = xb_add(&bar[XB_XSUB(b.x)], 1u);
        const unsigned gen = old / nloc;
        if (old + 1u == (gen + 1u) * nloc) {
            __builtin_amdgcn_fence(__ATOMIC_RELEASE, "agent");
            asm volatile("s_waitcnt vmcnt(0)" ::: "memory");
            const unsigned og = xb_add(&bar[XB_TOP], 1u);
            const unsigned tg = og / nx;
            if (og + 1u == (tg + 1u) * nx) xb_add(&bar[XB_TOPGEN], 1u);
            else XB_SPIN(xb_ld(&bar[XB_TOPGEN]) == tg, bar);
            __builtin_amdgcn_fence(__ATOMIC_ACQUIRE, "agent");
            xb_add(&bar[XB_XGEN(b.x)], 1u);
            asm volatile("s_waitcnt vmcnt(0)" ::: "memory");
        } else {
            XB_SPIN(xb_ld(&bar[XB_XGEN(b.x)]) == gen, bar);
            __builtin_amdgcn_fence(__ATOMIC_ACQUIRE, "agent");
            asm volatile("s_waitcnt vmcnt(0)" ::: "memory");
        }
    }
    __syncthreads();
}

__global__ void __launch_bounds__(256, 2) mega(Params p) {
  extern __shared__ __attribute__((aligned(16))) unsigned char smem[];
  const int nb = gridDim.x, bid = blockIdx.x;
  volatile LAS unsigned* xst = (volatile LAS unsigned*)(smem + LDS_BYTES - 16);
  if (threadIdx.x == 0) { xst[0] = 0u; xst[1] = 0u; xst[2] = 0u; xst[3] = 0u; }
  __syncthreads();
  XcdBarrier xb = xcd_barrier_post(p.bar, xst);
#pragma unroll 1
  for (int it = bid; it < 192 + 256 + 1024 + 256; it += nb) {
    if (it < 192) adaln_item(p, it, smem);
    else if (it < 448) rope_item(p, it - 192);
    else if (it < 1472) conv_tile(p.w_in, 4096, p.wt_in, it - 448, smem);
    else conv_tile(p.w_out, 1024, p.wt_out, it - 1472, smem);
  }
  xcd_barrier(xb);
#pragma unroll 1
  for (int l = 0; l < 4; ++l) {
#pragma unroll 1
    for (int rep = 0; rep < REP_P1 - 1; ++rep) prep_phase<1>(p, l, bid, nb);
    prep_phase<0>(p, l, bid, nb);
    {
      const int n = 768 + (l > 0 ? 256 : 0);
#pragma unroll 1
      for (int it = bid; it < n; it += nb) {
        if (it < 768) cache_conv_item(p, l, it);
        else conv_tile(p.w_out + (size_t)l * 1024 * 1024, 1024, p.wt_out, it - 768, smem);
      }
    }
    xcd_barrier(xb);
#pragma unroll 1
    for (int rep = 0; rep < REP_P2; ++rep)
#pragma unroll 1
    for (int it = bid; it < 2560; it += nb) gemm_big(p, l, it, smem);
    xcd_barrier(xb);
    for (int e = 0; e < EXTRA_SYNC; ++e) xcd_barrier(xb);
    {
      const int n = 128 + 128 + 1280 + 1280;
#pragma unroll 1
      for (int rep = 0; rep < REP_P3A; ++rep)
#pragma unroll 1
      for (int it = bid; it < n; it += nb) {
        if (it < 128) attn_item<0>(p, l, it, smem);
        else if (it < 256) attn_item<1>(p, l, it - 128, smem);
        else if (it < 1536) dsum_item(p, l, it - 256, smem);
        else csum_item(p, l, it - 1536, smem);
      }
    }
    xcd_barrier(xb);
    {
      const int n = 512 + 512 + 768 + 768;
#pragma unroll 1
      for (int rep = 0; rep < REP_P3B - 1; ++rep)
#pragma unroll 1
      for (int it = bid; it < 1024; it += nb) {
        if (it < 512) attn_item<2>(p, l, it, smem);
        else attn_item<3>(p, l, it - 512, smem);
      }
#pragma unroll 1
      for (int it = bid; it < n; it += nb) {
        if (it < 512) attn_item<2>(p, l, it, smem);
        else if (it < 1024) attn_item<3>(p, l, it - 512, smem);
        else if (it < 1792) scan_item<0>(p, l, it - 1024);
        else scan_item<1>(p, l, it - 1792);
      }
    }
    xcd_barrier(xb);
#pragma unroll 1
    for (int rep = 0; rep < REP_P3C; ++rep)
#pragma unroll 1
    for (int it = bid; it < 2560; it += nb) {
      if (it < 1280) dout_item(p, l, it, smem);
      else cout_item(p, l, it - 1280, smem);
    }
    if (l < 3 && bid >= (nb >> 1)) {
      const int hb = nb - (nb >> 1);
#pragma unroll 1
      for (int ci = bid - (nb >> 1); ci < 1024; ci += hb) conv_tile(p.w_in + (size_t)(l + 1) * 1024 * 4096, 4096, p.wt_in, ci, smem);
    }
    xcd_barrier(xb);
#pragma unroll 1
    for (int rep = 0; rep < REP_P4; ++rep)
#pragma unroll 1
    for (int it = bid; it < 1024; it += nb) gemm_out(p, it, smem);
    xcd_barrier(xb);
  }
  prep_phase<0>(p, 4, bid, nb);
}

extern "C" void kernel_launch(void* const* d_in, const int* in_sizes, int n_in, void* d_out, int out_size, void* d_ws,
                              size_t ws_size, hipStream_t stream) {
  static int grid_blocks = 0;
  if (!grid_blocks) {
    int dev = 0, cus = 0, per_cu = 0;
    hipGetDevice(&dev);
    hipDeviceGetAttribute(&cus, hipDeviceAttributeMultiprocessorCount, dev);
    hipFuncSetAttribute((const void*)mega, hipFuncAttributeMaxDynamicSharedMemorySize, LDS_BYTES);
    hipOccupancyMaxActiveBlocksPerMultiprocessor(&per_cu, (const void*)mega, 256, LDS_BYTES);
    if (per_cu < 1) per_cu = 1;
    if (per_cu > 2) per_cu = 2;
    grid_blocks = cus * per_cu;
  }
  Params p{};
  const float* const* in = (const float* const*)d_in;
  p.x_prompt = in[0]; p.x_sample = in[1]; p.c = in[2]; p.cwk = in[3]; p.cwv = in[4]; p.cnk = in[5]; p.cnv = in[6];
  p.st_ret = in[7]; p.st_hgrn = in[8]; p.c_ctx = in[9]; p.w_ada = in[10]; p.b_ada = in[11]; p.g_pre = in[12];
  p.g_post = in[13]; p.w_in = in[14]; p.w_out = in[15]; p.sink = in[16]; p.rpb = in[17]; p.ret_logit = in[18];
  p.lb_logit = in[19];
  p.out = (float*)d_out;
  unsigned char* ws = (unsigned char*)d_ws;
  size_t off = 0;
  p.wt_in = (u16*)(ws + off); off += (size_t)4096 * WS * 2;
  p.wt_out = (u16*)(ws + off); off += (size_t)1024 * WS * 2;
  p.hbuf = (u16*)(ws + off); off += (size_t)NTOK * HS * 2;
  p.proj = (u16*)(ws + off); p.ybuf = (u16*)(ws + off); off += (size_t)NTOK * 4096 * 2;
  p.uc = (u16*)(ws + off); off += (size_t)320 * 4 * 2 * 4096 * 2;
  p.ud = (u16*)(ws + off); off += (size_t)320 * 4 * 2 * 4096 * 2;
  p.dg = (float*)(ws + off); off += (size_t)320 * 4 * 2 * 64 * 4;
  p.mod = (float*)(ws + off); off += (size_t)4 * 9 * 3072 * 4;
  p.rope = (float*)(ws + off); off += (size_t)2048 * 32 * 2 * 4;
  p.bar = (unsigned*)(ws + off); off += (size_t)XCD_BAR_WORDS * 4;
  off = (off + 255) & ~(size_t)255;
  p.cbak = (u16*)(ws + off); off += (size_t)8 * 256 * 128 * 2;
  p.cbav = (u16*)(ws + off); off += (size_t)8 * 256 * 128 * 2;
  p.cbbk = (u16*)(ws + off); off += (size_t)8 * 256 * 256 * 2;
  p.cbbv = (u16*)(ws + off); off += (size_t)8 * 256 * 256 * 2;
  if (off > ws_size) { fprintf(stderr, "workspace too small: need %zu have %zu\n", off, ws_size); return; }
  if (hipMemsetAsync(p.bar, 0, (size_t)XCD_BAR_WORDS * 4, stream) != hipSuccess) { fprintf(stderr, "memset failed\n"); return; }
  void* args[] = {&p};
  hipError_t e = hipLaunchCooperativeKernel((const void*)mega, dim3(grid_blocks), dim3(256), args, LDS_BYTES, stream);
  if (e != hipSuccess) fprintf(stderr, "cooperative launch failed: %s (grid %d)\n", hipGetErrorString(e), grid_blocks);
}
```

```cpp
#include <hip/hip_runtime.h>
#include <hip/hip_cooperative_groups.h>
#include <cstdio>
#include <cstdint>
namespace cg = cooperative_groups;

typedef unsigned short u16;
typedef __attribute__((ext_vector_type(8))) short bf16x8;
typedef __attribute__((ext_vector_type(4))) float f32x4;

#define LOG2E 1.4426950408889634f
#define NTOK 20480
#define NCTX 4096
#define LDS_BYTES 75776
#define HS 1024
#define WS 1024
#ifndef REP_P1
#define REP_P1 1
#endif
#ifndef REP_SCAN
#define REP_SCAN 1
#endif
#ifndef REP_P2
#define REP_P2 1
#endif
#ifndef REP_P3A
#define REP_P3A 1
#endif
#ifndef REP_P3B
#define REP_P3B 1
#endif
#ifndef REP_P3C
#define REP_P3C 1
#endif
#ifndef REP_P4
#define REP_P4 1
#endif
#ifndef EXTRA_SYNC
#define EXTRA_SYNC 0
#endif

struct Params {
  const float *x_prompt, *x_sample, *c, *cwk, *cwv, *cnk, *cnv, *st_ret, *st_hgrn, *c_ctx,
      *w_ada, *b_ada, *g_pre, *g_post, *w_in, *w_out, *sink, *rpb, *ret_logit, *lb_logit;
  float* out;
  u16 *wt_in, *wt_out, *hbuf, *proj, *uc, *ud;
  float *dg, *mod, *rope;
  u16* ybuf;
  unsigned* bar;
  u16 *cbak, *cbav, *cbbk, *cbbv;
};

#define OUT_WK 20971520
#define OUT_WV 23068672
#define OUT_NK 25165824
#define OUT_NV 29360128
#define OUT_SR 33554432
#define OUT_SH 35651584

__device__ __forceinline__ int otid() { int t = threadIdx.x; asm volatile("" : "+v"(t)); return t; }
typedef __bf16 bf2_t __attribute__((ext_vector_type(2)));
__device__ __forceinline__ unsigned pack2(float a, float b) { bf2_t v; v[0] = (__bf16)a; v[1] = (__bf16)b; return __builtin_bit_cast(unsigned, v); }
__device__ __forceinline__ u16 f2bf(float f) { return (u16)(pack2(f, 0.f) & 0xffffu); }
__device__ __forceinline__ float bf2f(u16 h) { return __uint_as_float(((unsigned)h) << 16); }
__device__ __forceinline__ float bflo(unsigned u) { return __uint_as_float(u << 16); }
__device__ __forceinline__ float bfhi(unsigned u) { return __uint_as_float(u & 0xffff0000u); }
__device__ __forceinline__ float fexp2(float x) { return __builtin_amdgcn_exp2f(x); }
__device__ __forceinline__ float silu_f(float x) { return x / (1.f + __expf(-x)); }
__device__ __forceinline__ float wsum64(float v) {
#pragma unroll
  for (int o = 32; o >= 1; o >>= 1) v += __shfl_xor(v, o);
  return v;
}
#define DPPF(v, ctrl) __int_as_float(__builtin_amdgcn_update_dpp(0, __float_as_int(v), ctrl, 0xF, 0xF, true))
__device__ __forceinline__ float gsum16(float v) {
  v += DPPF(v, 0xB1); v += DPPF(v, 0x4E); v += DPPF(v, 0x141); v += DPPF(v, 0x140);
  return v;
}
__device__ __forceinline__ float gmax16(float v) {
  v = fmaxf(v, DPPF(v, 0xB1)); v = fmaxf(v, DPPF(v, 0x4E)); v = fmaxf(v, DPPF(v, 0x141)); v = fmaxf(v, DPPF(v, 0x140));
  return v;
}
__device__ __forceinline__ void wave_lds_sync() {
  __builtin_amdgcn_fence(__ATOMIC_RELEASE, "workgroup");
  __builtin_amdgcn_wave_barrier();
  __builtin_amdgcn_fence(__ATOMIC_ACQUIRE, "workgroup");
}
__device__ __forceinline__ f32x4 mfma16(bf16x8 a, bf16x8 b, f32x4 c) {
  return __builtin_amdgcn_mfma_f32_16x16x32_bf16(a, b, c, 0, 0, 0);
}
__device__ __forceinline__ bf16x8 ld8(const u16* p) { return *reinterpret_cast<const bf16x8*>(p); }

__device__ __forceinline__ float ret_lg2(const Params& p, int l, int dir, int h) {
  float x = p.ret_logit[(l * 2 + dir) * 4 + h];
  return -log1pf(expf(-x)) * LOG2E;
}
__device__ __forceinline__ float hgrn_lb(const Params& p, int l, int dir, int ch256) {
  float a0 = p.lb_logit[(0 * 2 + dir) * 256 + ch256], a1 = p.lb_logit[(1 * 2 + dir) * 256 + ch256];
  float a2 = p.lb_logit[(2 * 2 + dir) * 256 + ch256], a3 = p.lb_logit[(3 * 2 + dir) * 256 + ch256];
  float mx = fmaxf(fmaxf(a0, a1), fmaxf(a2, a3));
  float e0 = expf(a0 - mx), e1 = expf(a1 - mx), e2 = expf(a2 - mx), e3 = expf(a3 - mx);
  float inv = 1.f / (e0 + e1 + e2 + e3);
  float s = 0.f;
  if (l >= 1) s += e1;
  if (l >= 2) s += e2;
  if (l >= 3) s += e3;
  return s * inv;
}

__device__ void adaln_item(const Params& p, int it, unsigned char* smem) {
  float* sv = (float*)smem;
  float* red = sv + 9 * 1024;
  const int tid = otid(), w = tid >> 6, lane = tid & 63;
  const int l = it / 48, cb = (it % 48) * 64;
  __syncthreads();
  for (int i = tid; i < 9 * 1024; i += 256) {
    int v = i >> 10, k = i & 1023;
    float cv = v < 8 ? p.c[v * 1024 + k] : p.c_ctx[k];
    sv[i] = cv / (1.f + expf(-cv));
  }
  __syncthreads();
  const int col = cb + lane;
  const float* W = p.w_ada + (size_t)l * 1024 * 3072 + col;
  float acc[9];
#pragma unroll
  for (int v = 0; v < 9; ++v) acc[v] = 0.f;
#pragma unroll 1
  for (int k0 = w * 256; k0 < w * 256 + 256; k0 += 16) {
    float wv[16];
#pragma unroll
    for (int i = 0; i < 16; ++i) wv[i] = W[(size_t)(k0 + i) * 3072];
#pragma unroll
    for (int i = 0; i < 16; ++i)
#pragma unroll
      for (int v = 0; v < 9; ++v) acc[v] += sv[v * 1024 + k0 + i] * wv[i];
  }
#pragma unroll
  for (int v = 0; v < 9; ++v) red[(w * 9 + v) * 64 + lane] = acc[v];
  __syncthreads();
  if (tid < 64) {
    float bb = p.b_ada[l * 3072 + col];
#pragma unroll
    for (int v = 0; v < 9; ++v) {
      float s = red[(0 * 9 + v) * 64 + lane] + red[(1 * 9 + v) * 64 + lane] + red[(2 * 9 + v) * 64 + lane] + red[(3 * 9 + v) * 64 + lane];
      p.mod[(l * 9 + v) * 3072 + col] = s + bb;
    }
  }
  __syncthreads();
}

__device__ void rope_item(const Params& p, int it) {
  int idx = it * 256 + otid();
  int s = idx >> 5, i = idx & 31, fi = i & 15;
  float freq = powf(10000.f, -(float)fi / 16.f);
  int pos = (i < 16) ? (s >> 6) : (s & 63);
  float ang = (float)pos * freq;
  p.rope[idx * 2] = cosf(ang);
  p.rope[idx * 2 + 1] = sinf(ang);
}

__device__ void conv_tile(const float* src, int N, u16* dst, int tile, unsigned char* smem) {
  float* t = (float*)smem;
  const int tid = otid();
  const int ntn = N >> 6;
  const int k0 = (tile / ntn) * 64, n0 = (tile % ntn) * 64;
  __syncthreads();
#pragma unroll
  for (int r = 0; r < 16; ++r) {
    int row = r * 4 + (tid >> 6), col = tid & 63;
    t[row * 65 + col] = src[(size_t)(k0 + row) * N + n0 + col];
  }
  __syncthreads();
#pragma unroll
  for (int r = 0; r < 8; ++r) {
    int n = r * 8 + (tid >> 5), kp = tid & 31;
    unsigned v = pack2(t[(2 * kp) * 65 + n], t[(2 * kp + 1) * 65 + n]);
    *reinterpret_cast<unsigned*>(dst + (size_t)(n0 + n) * WS + k0 + 2 * kp) = v;
  }
  __syncthreads();
}


__device__ void cache_conv_item(const Params& p, int l, int it) {
  const int tid = otid();
  const float* src; u16* dst; int W, e0;
  if (it < 128) { src = p.cwk; dst = p.cbak; W = 128; e0 = it * 2048; }
  else if (it < 256) { src = p.cwv; dst = p.cbav; W = 128; e0 = (it - 128) * 2048; }
  else if (it < 512) { src = p.cnk; dst = p.cbbk; W = 256; e0 = (it - 256) * 2048; }
  else { src = p.cnv; dst = p.cbbv; W = 256; e0 = (it - 512) * 2048; }
  const int e = e0 + tid * 8;
  const int per_b = 256 * W, b = e / per_b, r = e - b * per_b;
  const float* sp = src + (size_t)((b * 4 + l) * 256) * W + r;
  float4 a = *reinterpret_cast<const float4*>(sp), c = *reinterpret_cast<const float4*>(sp + 4);
  uint4 o;
  o.x = pack2(a.x, a.y); o.y = pack2(a.z, a.w); o.z = pack2(c.x, c.y); o.w = pack2(c.z, c.w);
  *reinterpret_cast<uint4*>(dst + e) = o;
}
struct PrepRow { float4 x[4]; uint2 y[4]; float4 g[4], sh[4], sc[4]; };
__device__ __forceinline__ void prep_issue(const Params& p, int l, int T, int lane, PrepRow& r) {
  const int v = T < NCTX ? 8 : ((T - NCTX) >> 11);
  const float* xin = (l <= 1) ? (T < NCTX ? p.x_prompt + (size_t)T * 1024 : p.x_sample + (size_t)(T - NCTX) * 1024)
                              : p.out + (size_t)T * 1024;
#pragma unroll
  for (int i = 0; i < 4; ++i) r.x[i] = *reinterpret_cast<const float4*>(xin + (i * 64 + lane) * 4);
  if (l > 0) {
    const u16* yr = p.ybuf + (size_t)T * 1024;
    const float* gate = p.mod + ((l - 1) * 9 + v) * 3072 + 2048;
#pragma unroll
    for (int i = 0; i < 4; ++i) {
      const int col = (i * 64 + lane) * 4;
      r.y[i] = *reinterpret_cast<const uint2*>(yr + col);
      r.g[i] = *reinterpret_cast<const float4*>(gate + col);
    }
  }
  if (l < 4) {
    const float* md = p.mod + (l * 9 + v) * 3072;
#pragma unroll
    for (int i = 0; i < 4; ++i) {
      const int col = (i * 64 + lane) * 4;
      r.sh[i] = *reinterpret_cast<const float4*>(md + col);
      r.sc[i] = *reinterpret_cast<const float4*>(md + 1024 + col);
    }
  }
}
template <int DRY>
__device__ void prep_phase(const Params& p, int l, int bid, int nb) {
  const int tid = otid(), w = tid >> 6, lane = tid & 63;
  const int tstep = nb * 4;
  int T = bid * 4 + w;
  if (T >= NTOK) return;
  float4 pq[4], pgp[4];
#pragma unroll
  for (int i = 0; i < 4; ++i) {
    const int col = (i * 64 + lane) * 4;
    if (l > 0) pq[i] = *reinterpret_cast<const float4*>(p.g_post + (l - 1) * 1024 + col);
    if (l < 4) pgp[i] = *reinterpret_cast<const float4*>(p.g_pre + l * 1024 + col);
  }
  PrepRow cur, nxt;
  prep_issue(p, l, T, lane, nxt);
#pragma unroll 1
  for (; T < NTOK; T += tstep) {
    cur = nxt;
    if (T + tstep < NTOK) prep_issue(p, l, T + tstep, lane, nxt);
    float4 xv[4];
#pragma unroll
    for (int i = 0; i < 4; ++i) xv[i] = cur.x[i];
    if (l > 0) {
      float4 yv[4];
      float ss = 0.f;
#pragma unroll
      for (int i = 0; i < 4; ++i) {
        yv[i] = make_float4(bflo(cur.y[i].x), bfhi(cur.y[i].x), bflo(cur.y[i].y), bfhi(cur.y[i].y));
        ss += yv[i].x * yv[i].x + yv[i].y * yv[i].y + yv[i].z * yv[i].z + yv[i].w * yv[i].w;
      }
      ss = wsum64(ss);
      const float rstd = rsqrtf(ss * (1.f / 1024.f) + 1e-6f);
#pragma unroll
      for (int i = 0; i < 4; ++i) {
        const int col = (i * 64 + lane) * 4;
        xv[i].x += cur.g[i].x * (yv[i].x * rstd * pq[i].x);
        xv[i].y += cur.g[i].y * (yv[i].y * rstd * pq[i].y);
        xv[i].z += cur.g[i].z * (yv[i].z * rstd * pq[i].z);
        xv[i].w += cur.g[i].w * (yv[i].w * rstd * pq[i].w);
        if (!DRY) *reinterpret_cast<float4*>(p.out + (size_t)T * 1024 + col) = xv[i];
      }
    }
    if (l < 4) {
      float ss = 0.f;
#pragma unroll
      for (int i = 0; i < 4; ++i) ss += xv[i].x * xv[i].x + xv[i].y * xv[i].y + xv[i].z * xv[i].z + xv[i].w * xv[i].w;
      ss = wsum64(ss);
      const float rstd = rsqrtf(ss * (1.f / 1024.f) + 1e-6f);
#pragma unroll
      for (int i = 0; i < 4; ++i) {
        const int col = (i * 64 + lane) * 4;
        const float h0 = xv[i].x * rstd * pgp[i].x * (1.f + cur.sc[i].x) + cur.sh[i].x;
        const float h1 = xv[i].y * rstd * pgp[i].y * (1.f + cur.sc[i].y) + cur.sh[i].y;
        const float h2 = xv[i].z * rstd * pgp[i].z * (1.f + cur.sc[i].z) + cur.sh[i].z;
        const float h3 = xv[i].w * rstd * pgp[i].w * (1.f + cur.sc[i].w) + cur.sh[i].w;
        uint2 o;
        o.x = pack2(h0, h1);
        o.y = pack2(h2, h3);
        *reinterpret_cast<uint2*>(p.hbuf + (size_t)T * HS + col) = o;
      }
    }
  }
}

template <int MODE>
__device__ void gemm_tile(const Params& p, int l, int tile, unsigned char* smem) {
  u16* As = (u16*)smem;
  u16* Bs = As + 128 * 72;
  const int tid = otid(), w = tid >> 6, lane = tid & 63, r16 = lane & 15, quad = lane >> 4;
  const int wr = w >> 1, wc = w & 1;
  const int ntn = (MODE == 0) ? 32 : 8;
  const int ntm = (MODE == 0) ? 160 : 160;
  const int tm = tile % ntm, tn = tile / ntm;
  const u16* Agp = p.hbuf + (size_t)(tm * 128) * HS;
  const u16* Bgp = ((MODE == 0) ? p.wt_in : p.wt_out) + (size_t)(tn * 128) * WS;
  f32x4 acc[4][4];
#pragma unroll
  for (int a = 0; a < 4; ++a)
#pragma unroll
    for (int b = 0; b < 4; ++b) acc[a][b] = (f32x4){0.f, 0.f, 0.f, 0.f};
  const int lrow = tid >> 3, lkc = (tid & 7) * 8;
  const unsigned voff_Agp = lrow * HS + lkc, voff_Bgp = lrow * WS + lkc;
  u16* Asp = As + lrow * 72 + lkc;
  u16* Bsp = Bs + lrow * 72 + lkc;
  uint4 ra0, ra1, ra2, ra3, rb0, rb1, rb2, rb3;
#define GLD(p_, r_, S_) *reinterpret_cast<const uint4*>((p_) + ((size_t)(r_) * 32 * S_ + kofs) + voff_##p_)
#define GLOAD(KO) { const int kofs = (KO); \
  ra0 = GLD(Agp, 0, HS); ra1 = GLD(Agp, 1, HS); ra2 = GLD(Agp, 2, HS); ra3 = GLD(Agp, 3, HS); \
  rb0 = GLD(Bgp, 0, WS); rb1 = GLD(Bgp, 1, WS); rb2 = GLD(Bgp, 2, WS); rb3 = GLD(Bgp, 3, WS); }
#define SST(p_, st_, r_, v_) *reinterpret_cast<uint4*>((p_) + (st_) * (2 * 128 * 72) + (r_) * 32 * 72) = v_
#define STORE(st_) { SST(Asp, st_, 0, ra0); SST(Asp, st_, 1, ra1); SST(Asp, st_, 2, ra2); SST(Asp, st_, 3, ra3); \
                     SST(Bsp, st_, 0, rb0); SST(Bsp, st_, 1, rb1); SST(Bsp, st_, 2, rb2); SST(Bsp, st_, 3, rb3); }
  __syncthreads();
  GLOAD(0)
  STORE(0)
  GLOAD(64)
  __syncthreads();
#pragma unroll 1
  for (int kt = 0; kt < 16; ++kt) {
    const int cur = kt & 1;
    if (kt + 1 < 16) STORE(cur ^ 1)
    if (kt + 2 < 16) GLOAD((kt + 2) * 64)
    const u16* Ac = As + cur * (2 * 128 * 72);
    const u16* Bc = Bs + cur * (2 * 128 * 72);
    __builtin_amdgcn_s_setprio(1);
#pragma unroll
    for (int ks = 0; ks < 2; ++ks) {
      bf16x8 wf[4], xf[4];
#pragma unroll
      for (int i = 0; i < 4; ++i) {
        wf[i] = ld8(Bc + (wc * 64 + i * 16 + r16) * 72 + ks * 32 + quad * 8);
        xf[i] = ld8(Ac + (wr * 64 + i * 16 + r16) * 72 + ks * 32 + quad * 8);
      }
#pragma unroll
      for (int nt = 0; nt < 4; ++nt)
#pragma unroll
        for (int mt = 0; mt < 4; ++mt) acc[nt][mt] = mfma16(wf[nt], xf[mt], acc[nt][mt]);
    }
    __builtin_amdgcn_s_setprio(0);
    __syncthreads();
  }
#undef GLD
#undef GLOAD
#undef SST
#undef STORE
  const int colbase = tn * 128 + wc * 64;
  if (MODE == 0) {
    const bool ropeseg = (colbase < 384) || (colbase >= 1792 && colbase < 2304);
#pragma unroll
    for (int mt = 0; mt < 4; ++mt) {
      const int T = tm * 128 + wr * 64 + mt * 16 + r16;
      const bool lat = T >= NCTX;
      if (ropeseg && lat) {
        const int s = (T - NCTX) & 2047;
        const float* rp = p.rope + (size_t)(s * 32 + quad * 4) * 2;
        float4 c0 = *reinterpret_cast<const float4*>(rp);
        float4 c1 = *reinterpret_cast<const float4*>(rp + 4);
        float4 d0 = *reinterpret_cast<const float4*>(rp + 32);
        float4 d1 = *reinterpret_cast<const float4*>(rp + 36);
        float cs[4] = {c0.x, c0.z, c1.x, c1.z}, sn[4] = {c0.y, c0.w, c1.y, c1.w};
        float cs2[4] = {d0.x, d0.z, d1.x, d1.z}, sn2[4] = {d0.y, d0.w, d1.y, d1.w};
#pragma unroll
        for (int j = 0; j < 4; ++j) {
          float x1 = acc[0][mt][j], x2 = acc[1][mt][j];
          acc[0][mt][j] = x1 * cs[j] - x2 * sn[j];
          acc[1][mt][j] = x2 * cs[j] + x1 * sn[j];
          float y1 = acc[2][mt][j], y2 = acc[3][mt][j];
          acc[2][mt][j] = y1 * cs2[j] - y2 * sn2[j];
          acc[3][mt][j] = y2 * cs2[j] + y1 * sn2[j];
        }
      }
#pragma unroll
      for (int nt = 0; nt < 4; ++nt) {
        const int col = colbase + nt * 16 + quad * 4;
        uint2 o;
        o.x = pack2(acc[nt][mt][0], acc[nt][mt][1]);
        o.y = pack2(acc[nt][mt][2], acc[nt][mt][3]);
        *reinterpret_cast<uint2*>(p.proj + (size_t)T * 4096 + col) = o;
        if (!lat) {
          const int b = T >> 8, s = T & 255;
          float4 f = {acc[nt][mt][0], acc[nt][mt][1], acc[nt][mt][2], acc[nt][mt][3]};
          const size_t rowi = (size_t)((b * 4 + l) * 256 + s);
          if (col >= 256 && col < 384) *reinterpret_cast<float4*>(p.out + OUT_WK + rowi * 128 + (col - 256)) = f;
          else if (col >= 384 && col < 512) *reinterpret_cast<float4*>(p.out + OUT_WV + rowi * 128 + (col - 384)) = f;
          else if (col >= 1024 && col < 1280) *reinterpret_cast<float4*>(p.out + OUT_NK + rowi * 256 + (col - 1024)) = f;
          else if (col >= 1280 && col < 1536) *reinterpret_cast<float4*>(p.out + OUT_NV + rowi * 256 + (col - 1280)) = f;
        }
      }
    }
  } else {
#pragma unroll
    for (int mt = 0; mt < 4; ++mt) {
      const int T = tm * 128 + wr * 64 + mt * 16 + r16;
#pragma unroll
      for (int nt = 0; nt < 4; ++nt) {
        const int col = colbase + nt * 16 + quad * 4;
        uint2 o;
        o.x = pack2(acc[nt][mt][0], acc[nt][mt][1]);
        o.y = pack2(acc[nt][mt][2], acc[nt][mt][3]);
        *reinterpret_cast<uint2*>(p.ybuf + (size_t)T * 1024 + col) = o;
      }
    }
  }
}

__device__ void gemm_out(const Params& p, int tile, unsigned char* smem) {
  u16* As = (u16*)smem;
  u16* Bs = As + 160 * 72;
  const int tid = otid(), w = tid >> 6, lane = tid & 63, r16 = lane & 15, quad = lane >> 4;
  const int wr = w >> 1, wc = w & 1;
  const int tm = tile & 127, tn = tile >> 7;
  const u16* Agp = p.hbuf + (size_t)(tm * 160) * HS;
  const u16* Bgp = p.wt_out + (size_t)(tn * 128) * WS;
  f32x4 acc[4][5];
#pragma unroll
  for (int a = 0; a < 4; ++a)
#pragma unroll
    for (int b = 0; b < 5; ++b) acc[a][b] = (f32x4){0.f, 0.f, 0.f, 0.f};
  const int lrow = tid >> 3, lkc = (tid & 7) * 8;
  const unsigned voff_Agp = lrow * HS + lkc, voff_Bgp = lrow * WS + lkc;
  u16* Asp = As + lrow * 72 + lkc;
  u16* Bsp = Bs + lrow * 72 + lkc;
  uint4 ra0, ra1, ra2, ra3, ra4, rb0, rb1, rb2, rb3;
#define GLD(p_, r_, S_) *reinterpret_cast<const uint4*>((p_) + ((size_t)(r_) * 32 * S_ + kofs) + voff_##p_)
#define GLOADO(KO) { const int kofs = (KO); \
  ra0 = GLD(Agp, 0, HS); ra1 = GLD(Agp, 1, HS); ra2 = GLD(Agp, 2, HS); ra3 = GLD(Agp, 3, HS); ra4 = GLD(Agp, 4, HS); \
  rb0 = GLD(Bgp, 0, WS); rb1 = GLD(Bgp, 1, WS); rb2 = GLD(Bgp, 2, WS); rb3 = GLD(Bgp, 3, WS); }
#define SST(p_, r_, v_) *reinterpret_cast<uint4*>((p_) + (r_) * 32 * 72) = v_
  GLOADO(0)
#pragma unroll 1
  for (int kt = 0; kt < 16; ++kt) {
    __syncthreads();
    SST(Asp, 0, ra0); SST(Asp, 1, ra1); SST(Asp, 2, ra2); SST(Asp, 3, ra3); SST(Asp, 4, ra4);
    SST(Bsp, 0, rb0); SST(Bsp, 1, rb1); SST(Bsp, 2, rb2); SST(Bsp, 3, rb3);
    if (kt + 1 < 16) GLOADO((kt + 1) * 64)
    __syncthreads();
    {
      bf16x8 wf0[4], xf0[5], wf1[4], xf1[5];
#pragma unroll
      for (int i = 0; i < 4; ++i) wf0[i] = ld8(Bs + (wc * 64 + i * 16 + r16) * 72 + quad * 8);
#pragma unroll
      for (int i = 0; i < 5; ++i) xf0[i] = ld8(As + (wr * 80 + i * 16 + r16) * 72 + quad * 8);
#pragma unroll
      for (int i = 0; i < 4; ++i) wf1[i] = ld8(Bs + (wc * 64 + i * 16 + r16) * 72 + 32 + quad * 8);
#pragma unroll
      for (int i = 0; i < 5; ++i) xf1[i] = ld8(As + (wr * 80 + i * 16 + r16) * 72 + 32 + quad * 8);
      __builtin_amdgcn_sched_barrier(0);
      __builtin_amdgcn_s_setprio(1);
#pragma unroll
      for (int mt = 0; mt < 5; ++mt)
#pragma unroll
        for (int nt = 0; nt < 4; ++nt) acc[nt][mt] = mfma16(wf0[nt], xf0[mt], acc[nt][mt]);
#pragma unroll
      for (int mt = 0; mt < 5; ++mt)
#pragma unroll
        for (int nt = 0; nt < 4; ++nt) acc[nt][mt] = mfma16(wf1[nt], xf1[mt], acc[nt][mt]);
      __builtin_amdgcn_s_setprio(0);
    }
  }
#undef GLD
#undef GLOADO
#undef SST
  const int colbase = tn * 128 + wc * 64;
#pragma unroll
  for (int mt = 0; mt < 5; ++mt) {
    const int T = tm * 160 + wr * 80 + mt * 16 + r16;
#pragma unroll
    for (int nt = 0; nt < 4; ++nt) {
      const int col = colbase + nt * 16 + quad * 4;
      uint2 o;
      o.x = pack2(acc[nt][mt][0], acc[nt][mt][1]);
      o.y = pack2(acc[nt][mt][2], acc[nt][mt][3]);
      *reinterpret_cast<uint2*>(p.ybuf + (size_t)T * 1024 + col) = o;
    }
  }
}

__device__ void gemm_big(const Params& p, int l, int tile, unsigned char* smem) {
  u16* As = (u16*)smem;
  u16* Bs = As + 256 * 72;
  const int tid = otid(), w = tid >> 6, lane = tid & 63, r16 = lane & 15, quad = lane >> 4;
  const int wr = w >> 1, wc = w & 1;
  int tm, tn;
  {
    const int r = tile >> 9, x = tile & 7, sl = (tile & 511) >> 3;
    const int R = r * 8 + x;
    tm = (R % 10) * 8 + (sl & 7);
    tn = (R / 10) * 8 + (sl >> 3);
  }
  const u16* Ag = p.hbuf + (size_t)(tm * 256) * HS;
  const u16* Bg = p.wt_in + (size_t)(tn * 128) * WS;
  f32x4 acc[4][8];
#pragma unroll
  for (int a = 0; a < 4; ++a)
#pragma unroll
    for (int b = 0; b < 8; ++b) acc[a][b] = (f32x4){0.f, 0.f, 0.f, 0.f};
  const int lrow = tid >> 3, lkc = (tid & 7) * 8;
  const u16* Agp = Ag + (size_t)lrow * HS + lkc;
  const u16* Bgp = Bg + (size_t)lrow * WS + lkc;
  u16* Asp = As + lrow * 72 + lkc;
  u16* Bsp = Bs + lrow * 72 + lkc;
  uint4 ra0, ra1, ra2, ra3, ra4, ra5, ra6, ra7, rb0, rb1, rb2, rb3;
#define GLD(p_, r_, S_) *reinterpret_cast<const uint4*>((p_) + (size_t)(r_) * 32 * S_ + kofs)
#define GLOADB(KO) { const int kofs = (KO); \
  ra0 = GLD(Agp, 0, HS); ra1 = GLD(Agp, 1, HS); ra2 = GLD(Agp, 2, HS); ra3 = GLD(Agp, 3, HS); ra4 = GLD(Agp, 4, HS); ra5 = GLD(Agp, 5, HS); ra6 = GLD(Agp, 6, HS); ra7 = GLD(Agp, 7, HS); \
  rb0 = GLD(Bgp, 0, WS); rb1 = GLD(Bgp, 1, WS); rb2 = GLD(Bgp, 2, WS); rb3 = GLD(Bgp, 3, WS); }
#define SST(p_, r_, v_) *reinterpret_cast<uint4*>((p_) + (r_) * 32 * 72) = v_
  GLOADB(0)
#pragma unroll 1
  for (int kt = 0; kt < 16; ++kt) {
    __syncthreads();
    SST(Asp, 0, ra0); SST(Asp, 1, ra1); SST(Asp, 2, ra2); SST(Asp, 3, ra3); SST(Asp, 4, ra4); SST(Asp, 5, ra5); SST(Asp, 6, ra6); SST(Asp, 7, ra7);
    SST(Bsp, 0, rb0); SST(Bsp, 1, rb1); SST(Bsp, 2, rb2); SST(Bsp, 3, rb3);
    if (kt + 1 < 16) GLOADB((kt + 1) * 64)
    __syncthreads();
    {
      const u16* Bb = Bs + (wc * 64 + r16) * 72 + quad * 8;
      const u16* Ab = As + (wr * 128 + r16) * 72 + quad * 8;
      bf16x8 wf0[4], wf1[4], xr[3];
#pragma unroll
      for (int i = 0; i < 4; ++i) wf0[i] = ld8(Bb + i * 16 * 72);
#pragma unroll
      for (int i = 0; i < 2; ++i) xr[i] = ld8(Ab + i * 16 * 72);
#pragma unroll
      for (int i = 0; i < 4; ++i) wf1[i] = ld8(Bb + i * 16 * 72 + 32);
      __builtin_amdgcn_sched_barrier(0);
      __builtin_amdgcn_s_setprio(1);
#pragma unroll
      for (int st = 0; st < 16; ++st) {
        const int nx = st + 2;
        if (nx < 16) xr[nx % 3] = ld8(Ab + (nx & 7) * 16 * 72 + (nx >> 3) * 32);
        __builtin_amdgcn_sched_barrier(0);
        const int mt = st & 7;
        if (st < 8) {
#pragma unroll
          for (int nt = 0; nt < 4; ++nt) acc[nt][mt] = mfma16(wf0[nt], xr[st % 3], acc[nt][mt]);
        } else {
#pragma unroll
          for (int nt = 0; nt < 4; ++nt) acc[nt][mt] = mfma16(wf1[nt], xr[st % 3], acc[nt][mt]);
        }
        __builtin_amdgcn_sched_barrier(0);
      }
      __builtin_amdgcn_s_setprio(0);
    }
  }
#undef GLD
#undef GLOADB
#undef SST
  const int colbase = tn * 128 + wc * 64;
  const bool ropeseg = (colbase < 384) || (colbase >= 1792 && colbase < 2304);
  __syncthreads();
  u16* stg = (u16*)smem + w * (64 * 72);
#pragma unroll
  for (int half = 0; half < 2; ++half) {
#pragma unroll
    for (int mtl = 0; mtl < 4; ++mtl) {
      const int mt = half * 4 + mtl;
      const int T = tm * 256 + wr * 128 + mt * 16 + r16;
      const bool lat = T >= NCTX;
      if (ropeseg && lat) {
        const int s = (T - NCTX) & 2047;
        const float* rp = p.rope + (size_t)(s * 32 + quad * 4) * 2;
        float4 c0 = *reinterpret_cast<const float4*>(rp);
        float4 c1 = *reinterpret_cast<const float4*>(rp + 4);
        float4 d0 = *reinterpret_cast<const float4*>(rp + 32);
        float4 d1 = *reinterpret_cast<const float4*>(rp + 36);
        float cs[4] = {c0.x, c0.z, c1.x, c1.z}, sn[4] = {c0.y, c0.w, c1.y, c1.w};
        float cs2[4] = {d0.x, d0.z, d1.x, d1.z}, sn2[4] = {d0.y, d0.w, d1.y, d1.w};
#pragma unroll
        for (int j = 0; j < 4; ++j) {
          float x1 = acc[0][mt][j], x2 = acc[1][mt][j];
          acc[0][mt][j] = x1 * cs[j] - x2 * sn[j];
          acc[1][mt][j] = x2 * cs[j] + x1 * sn[j];
          float y1 = acc[2][mt][j], y2 = acc[3][mt][j];
          acc[2][mt][j] = y1 * cs2[j] - y2 * sn2[j];
          acc[3][mt][j] = y2 * cs2[j] + y1 * sn2[j];
        }
      }
#pragma unroll
      for (int nt = 0; nt < 4; ++nt) {
        uint2 o;
        o.x = pack2(acc[nt][mt][0], acc[nt][mt][1]);
        o.y = pack2(acc[nt][mt][2], acc[nt][mt][3]);
        *reinterpret_cast<uint2*>(stg + (mtl * 16 + r16) * 72 + nt * 16 + quad * 4) = o;
        if (!lat) {
          const int col = colbase + nt * 16 + quad * 4;
          const int b = T >> 8, s = T & 255;
          float4 f = {acc[nt][mt][0], acc[nt][mt][1], acc[nt][mt][2], acc[nt][mt][3]};
          const size_t rowi = (size_t)((b * 4 + l) * 256 + s);
          if (col >= 256 && col < 384) *reinterpret_cast<float4*>(p.out + OUT_WK + rowi * 128 + (col - 256)) = f;
          else if (col >= 384 && col < 512) *reinterpret_cast<float4*>(p.out + OUT_WV + rowi * 128 + (col - 384)) = f;
          else if (col >= 1024 && col < 1280) *reinterpret_cast<float4*>(p.out + OUT_NK + rowi * 256 + (col - 1024)) = f;
          else if (col >= 1280 && col < 1536) *reinterpret_cast<float4*>(p.out + OUT_NV + rowi * 256 + (col - 1280)) = f;
        }
      }
    }
    wave_lds_sync();
#pragma unroll
    for (int i = 0; i < 8; ++i) {
      const int row = i * 8 + (lane >> 3), ch = lane & 7;
      uint4 v = *reinterpret_cast<const uint4*>(stg + row * 72 + ch * 8);
      const int T = tm * 256 + wr * 128 + half * 64 + row;
      *reinterpret_cast<uint4*>(p.proj + (size_t)T * 4096 + colbase + ch * 8) = v;
    }
    wave_lds_sync();
  }
}

__device__ __forceinline__ void ld_rows_bf16(u16* dst, const u16* src, size_t stride) {
  const int tid = otid(), row = tid >> 2, part = (tid & 3) * 16;
  const u16* s = src + (size_t)row * stride + part;
  uint4 a = *reinterpret_cast<const uint4*>(s);
  uint4 b = *reinterpret_cast<const uint4*>(s + 8);
  *reinterpret_cast<uint4*>(dst + row * 72 + part) = a;
  *reinterpret_cast<uint4*>(dst + row * 72 + part + 8) = b;
}
__device__ __forceinline__ void ld_rows_f32(u16* dst, const float* src, size_t stride) {
  const int tid = otid(), row = tid >> 2, part = (tid & 3) * 16;
  const float* s = src + (size_t)row * stride + part;
  float4 a = *reinterpret_cast<const float4*>(s), b = *reinterpret_cast<const float4*>(s + 4);
  float4 c = *reinterpret_cast<const float4*>(s + 8), d = *reinterpret_cast<const float4*>(s + 12);
  uint4 o0, o1;
  o0.x = pack2(a.x, a.y); o0.y = pack2(a.z, a.w); o0.z = pack2(b.x, b.y); o0.w = pack2(b.z, b.w);
  o1.x = pack2(c.x, c.y); o1.y = pack2(c.z, c.w); o1.z = pack2(d.x, d.y); o1.w = pack2(d.z, d.w);
  *reinterpret_cast<uint4*>(dst + row * 72 + part) = o0;
  *reinterpret_cast<uint4*>(dst + row * 72 + part + 8) = o1;
}
__device__ __forceinline__ void ld_tr_bf16(u16* dst, const u16* src, size_t stride) {
  const int tid = otid(), dc = tid >> 5, kp = tid & 31;
  uint4 a = *reinterpret_cast<const uint4*>(src + (size_t)(2 * kp) * stride + dc * 8);
  uint4 b = *reinterpret_cast<const uint4*>(src + (size_t)(2 * kp + 1) * stride + dc * 8);
  unsigned av[4] = {a.x, a.y, a.z, a.w}, bv[4] = {b.x, b.y, b.z, b.w};
#pragma unroll
  for (int i = 0; i < 4; ++i) {
    unsigned lo = (av[i] & 0xffffu) | (bv[i] << 16);
    unsigned hi = (av[i] >> 16) | (bv[i] & 0xffff0000u);
    *reinterpret_cast<unsigned*>(dst + (dc * 8 + 2 * i) * 72 + 2 * kp) = lo;
    *reinterpret_cast<unsigned*>(dst + (dc * 8 + 2 * i + 1) * 72 + 2 * kp) = hi;
  }
}
__device__ __forceinline__ void ld_tr_f32(u16* dst, const float* src, size_t stride) {
  const int tid = otid(), dc = tid >> 5, kp = tid & 31;
  const float* s0 = src + (size_t)(2 * kp) * stride + dc * 8;
  const float* s1 = src + (size_t)(2 * kp + 1) * stride + dc * 8;
  float4 a0 = *reinterpret_cast<const float4*>(s0), a1 = *reinterpret_cast<const float4*>(s0 + 4);
  float4 b0 = *reinterpret_cast<const float4*>(s1), b1 = *reinterpret_cast<const float4*>(s1 + 4);
  float av[8] = {a0.x, a0.y, a0.z, a0.w, a1.x, a1.y, a1.z, a1.w};
  float bv[8] = {b0.x, b0.y, b0.z, b0.w, b1.x, b1.y, b1.z, b1.w};
#pragma unroll
  for (int i = 0; i < 8; ++i) *reinterpret_cast<unsigned*>(dst + (dc * 8 + i) * 72 + 2 * kp) = pack2(av[i], bv[i]);
}

#define DEFER_THR 10.0f
template <int NSUB, class F>
__device__ __forceinline__ void attn_step(const u16* Ksh, const u16* Vt, int kbeg, const bf16x8 (&aq)[2],
                                          f32x4 (&o)[4], float& m, float& ls, F maskf, int r16, int quad) {
  f32x4 st[NSUB];
#pragma unroll
  for (int t = 0; t < NSUB; ++t) {
    st[t] = (f32x4){0.f, 0.f, 0.f, 0.f};
#pragma unroll
    for (int ks = 0; ks < 2; ++ks) st[t] = mfma16(ld8(Ksh + (kbeg + t * 16 + r16) * 72 + ks * 32 + quad * 8), aq[ks], st[t]);
  }
  float mx = -1e30f;
#pragma unroll
  for (int t = 0; t < NSUB; ++t)
#pragma unroll
    for (int j = 0; j < 4; ++j) {
      st[t][j] = maskf(kbeg + t * 16 + quad * 4 + j, st[t][j] * (0.125f * LOG2E));
      mx = fmaxf(mx, st[t][j]);
    }
  mx = fmaxf(mx, __shfl_xor(mx, 16));
  mx = fmaxf(mx, __shfl_xor(mx, 32));
  float al = 1.f;
  __builtin_amdgcn_sched_barrier(0);
  if (__any(mx - m > DEFER_THR)) {
    const float mn = fmaxf(m, mx);
    al = fexp2(m - mn);
    m = mn;
#pragma unroll
    for (int n = 0; n < 4; ++n)
#pragma unroll
      for (int j = 0; j < 4; ++j) o[n][j] *= al;
  }
  __builtin_amdgcn_sched_barrier(0);
  float rs = 0.f;
#pragma unroll
  for (int t = 0; t < NSUB; ++t)
#pragma unroll
    for (int j = 0; j < 4; ++j) {
      float pv = fexp2(st[t][j] - m);
      st[t][j] = pv;
      rs += pv;
    }
  ls = ls * al + rs;
#pragma unroll
  for (int s2 = 0; s2 < NSUB / 2; ++s2) {
    union { unsigned u[4]; bf16x8 v; } bp;
    bp.u[0] = pack2(st[2 * s2][0], st[2 * s2][1]);
    bp.u[1] = pack2(st[2 * s2][2], st[2 * s2][3]);
    bp.u[2] = pack2(st[2 * s2 + 1][0], st[2 * s2 + 1][1]);
    bp.u[3] = pack2(st[2 * s2 + 1][2], st[2 * s2 + 1][3]);
#pragma unroll
    for (int n = 0; n < 4; ++n) {
      const u16* vp = Vt + (n * 16 + r16) * 72 + kbeg + s2 * 32 + quad * 4;
      union { uint2 h[2]; bf16x8 v; } av;
      av.h[0] = *reinterpret_cast<const uint2*>(vp);
      av.h[1] = *reinterpret_cast<const uint2*>(vp + 16);
      o[n] = mfma16(av.v, bp.v, o[n]);
    }
  }
}

struct KVb { uint4 k0, k1, v0, v1; };
struct KVf { float4 k0, k1, k2, k3, v0, v1, v2, v3; };
__device__ __forceinline__ void kv_issue_b(uint4& rk0, uint4& rk1, uint4& rv0, uint4& rv1, const u16* ks, const u16* vs, size_t stride, int tid) {
  const int row = tid >> 2, part = (tid & 3) * 16;
  const u16* s = ks + (size_t)row * stride + part;
  rk0 = *reinterpret_cast<const uint4*>(s);
  rk1 = *reinterpret_cast<const uint4*>(s + 8);
  const int dc = tid >> 5, kp = tid & 31;
  rv0 = *reinterpret_cast<const uint4*>(vs + (size_t)(2 * kp) * stride + dc * 8);
  rv1 = *reinterpret_cast<const uint4*>(vs + (size_t)(2 * kp + 1) * stride + dc * 8);
}
__device__ __forceinline__ void kv_commit_b(const uint4& rk0, const uint4& rk1, const uint4& rv0, const uint4& rv1, u16* Ksh, u16* Vt, int tid) {
  const int row = tid >> 2, part = (tid & 3) * 16;
  *reinterpret_cast<uint4*>(Ksh + row * 72 + part) = rk0;
  *reinterpret_cast<uint4*>(Ksh + row * 72 + part + 8) = rk1;
  const int dc = tid >> 5, kp = tid & 31;
  unsigned av[4] = {rv0.x, rv0.y, rv0.z, rv0.w}, bv[4] = {rv1.x, rv1.y, rv1.z, rv1.w};
#pragma unroll
  for (int i = 0; i < 4; ++i) {
    unsigned lo = (av[i] & 0xffffu) | (bv[i] << 16);
    unsigned hi = (av[i] >> 16) | (bv[i] & 0xffff0000u);
    *reinterpret_cast<unsigned*>(Vt + (dc * 8 + 2 * i) * 72 + 2 * kp) = lo;
    *reinterpret_cast<unsigned*>(Vt + (dc * 8 + 2 * i + 1) * 72 + 2 * kp) = hi;
  }
}
__device__ __forceinline__ void kv_issue_f(float4& fk0, float4& fk1, float4& fk2, float4& fk3, float4& fv0, float4& fv1, float4& fv2, float4& fv3, const float* ks, const float* vs, size_t stride, int tid) {
  const int row = tid >> 2, part = (tid & 3) * 16;
  const float* s = ks + (size_t)row * stride + part;
  fk0 = *reinterpret_cast<const float4*>(s);
  fk1 = *reinterpret_cast<const float4*>(s + 4);
  fk2 = *reinterpret_cast<const float4*>(s + 8);
  fk3 = *reinterpret_cast<const float4*>(s + 12);
  const int dc = tid >> 5, kp = tid & 31;
  const float* s0 = vs + (size_t)(2 * kp) * stride + dc * 8;
  const float* s1 = vs + (size_t)(2 * kp + 1) * stride + dc * 8;
  fv0 = *reinterpret_cast<const float4*>(s0);
  fv1 = *reinterpret_cast<const float4*>(s0 + 4);
  fv2 = *reinterpret_cast<const float4*>(s1);
  fv3 = *reinterpret_cast<const float4*>(s1 + 4);
}
__device__ __forceinline__ void kv_commit_f(const float4& fk0, const float4& fk1, const float4& fk2, const float4& fk3, const float4& fv0, const float4& fv1, const float4& fv2, const float4& fv3, u16* Ksh, u16* Vt, int tid) {
  const int row = tid >> 2, part = (tid & 3) * 16;
  uint4 o0, o1;
  o0.x = pack2(fk0.x, fk0.y); o0.y = pack2(fk0.z, fk0.w); o0.z = pack2(fk1.x, fk1.y); o0.w = pack2(fk1.z, fk1.w);
  o1.x = pack2(fk2.x, fk2.y); o1.y = pack2(fk2.z, fk2.w); o1.z = pack2(fk3.x, fk3.y); o1.w = pack2(fk3.z, fk3.w);
  *reinterpret_cast<uint4*>(Ksh + row * 72 + part) = o0;
  *reinterpret_cast<uint4*>(Ksh + row * 72 + part + 8) = o1;
  const int dc = tid >> 5, kp = tid & 31;
  float av[8] = {fv0.x, fv0.y, fv0.z, fv0.w, fv1.x, fv1.y, fv1.z, fv1.w};
  float bv[8] = {fv2.x, fv2.y, fv2.z, fv2.w, fv3.x, fv3.y, fv3.z, fv3.w};
#pragma unroll
  for (int i = 0; i < 8; ++i) *reinterpret_cast<unsigned*>(Vt + (dc * 8 + i) * 72 + 2 * kp) = pack2(av[i], bv[i]);
}

template <int KIND>
__device__ void attn_item(const Params& p, int l, int it, unsigned char* smem) {
  u16* Ksh = (u16*)smem;
  u16* Vt = Ksh + 64 * 72;
  float* rpbs = (float*)(Vt + 64 * 72);
  const int tid = otid(), w = tid >> 6, lane = tid & 63, r16 = lane & 15, quad = lane >> 4;
  int b, h, qt, Tq0;
  if (KIND < 2) { b = it >> 3; h = (it >> 1) & 3; qt = it & 1; Tq0 = b * 256 + qt * 128; }
  else { b = it >> 6; h = (it >> 4) & 3; qt = it & 15; Tq0 = NCTX + b * 2048 + qt * 128; }
  const bool isA = (KIND == 0 || KIND == 2);
  const int qcol = isA ? 0 : 768, gcol = isA ? 512 : 1536, mixcol = isA ? 0 : 256;
  const int kv = h >> 1;
  int qoff[2];
  if (KIND == 3) { qoff[0] = (w >> 1) * 64 + (w & 1) * 32; qoff[1] = qoff[0] + 16; }
  else { qoff[0] = w * 32; qoff[1] = w * 32 + 16; }
  bf16x8 aq[2][2];
  uint2 gpre[2][4];
#pragma unroll
  for (int g = 0; g < 2; ++g) {
    const size_t rowo = (size_t)(Tq0 + qoff[g] + r16) * 4096;
    const u16* qp = p.proj + rowo + qcol + h * 64 + quad * 8;
    aq[g][0] = ld8(qp);
    aq[g][1] = ld8(qp + 32);
    const u16* gp = p.proj + rowo + gcol + h * 64 + quad * 4;
#pragma unroll
    for (int n = 0; n < 4; ++n) gpre[g][n] = *reinterpret_cast<const uint2*>(gp + n * 16);
  }
  f32x4 o[2][4];
  float m[2] = {-1e30f, -1e30f}, ls[2] = {0.f, 0.f};
#pragma unroll
  for (int g = 0; g < 2; ++g)
#pragma unroll
    for (int n = 0; n < 4; ++n) o[g][n] = (f32x4){0.f, 0.f, 0.f, 0.f};
  auto nomask = [](int, float s) { return s; };

  int nloc, loc0, ktlo = 0, R0 = 0;
  const int kcol = isA ? 256 + kv * 64 : 1024 + h * 64;
  const int vcol = isA ? 384 + kv * 64 : 1280 + h * 64;
  if (KIND < 2) { nloc = 4; loc0 = b * 256; }
  else if (KIND == 2) {
    ktlo = 2 * qt - 2; if (ktlo < 0) ktlo = 0;
    int kthi = 2 * qt + 3; if (kthi > 31) kthi = 31;
    nloc = kthi - ktlo + 1;
    loc0 = NCTX + b * 2048 + ktlo * 64;
  } else {
    const int r0 = 2 * qt;
    R0 = r0 - 4; R0 = R0 < 0 ? 0 : (R0 > 24 ? 24 : R0);
    int R1 = r0 + 1 - 4; R1 = R1 < 0 ? 0 : (R1 > 24 ? 24 : R1);
    nloc = R1 + 8 - R0;
    loc0 = NCTX + b * 2048 + R0 * 64;
  }
  const int ntot = nloc + (KIND >= 2 ? 4 : 0);
  const u16* ck = nullptr; const u16* cv = nullptr; int cstride = 0;
  if (KIND == 2) { const size_t ro = (size_t)(b * 256) * 128 + kv * 64; ck = p.cbak + ro; cv = p.cbav + ro; cstride = 128; }
  if (KIND == 3) { const size_t ro = (size_t)(b * 256) * 256 + h * 64; ck = p.cbbk + ro; cv = p.cbbv + ro; cstride = 256; }
  int kbeg[2] = {0, 0};
  int myrow = 0, myR0 = 0;
  if (KIND == 3) {
    myrow = 2 * qt + (w >> 1);
    myR0 = myrow - 4; myR0 = myR0 < 0 ? 0 : (myR0 > 24 ? 24 : myR0);
#pragma unroll
    for (int g = 0; g < 2; ++g) {
      const int cb = (w & 1) * 2 + g;
      int kb = 16 * cb - 8; kb = kb < 0 ? 0 : (kb > 32 ? 32 : kb);
      kbeg[g] = kb;
    }
    __syncthreads();
    for (int i = tid; i < 15 * 31; i += 256) rpbs[i] = p.rpb[(size_t)((l * 4 + h) * 15) * 31 + i] * LOG2E;
  }
  uint4 ak0, ak1, av0, av1, bk0, bk1, bv0, bv1;
  auto issue = [&](int vt, uint4& k0, uint4& k1, uint4& v0, uint4& v1) {
    if (vt < nloc) {
      const u16* base = p.proj + (size_t)(loc0 + vt * 64) * 4096;
      kv_issue_b(k0, k1, v0, v1, base + kcol, base + vcol, 4096, tid);
    } else {
      const size_t ro = (size_t)((vt - nloc) * 64) * cstride;
      kv_issue_b(k0, k1, v0, v1, ck + ro, cv + ro, (size_t)cstride, tid);
    }
  };
  auto do_step = [&](int vt) {
#pragma unroll
    for (int g = 0; g < 2; ++g) {
      if (vt >= nloc || KIND < 2) {
        attn_step<4>(Ksh, Vt, 0, aq[g], o[g], m[g], ls[g], nomask, r16, quad);
      } else if (KIND == 2) {
        const int kpos0 = (ktlo + vt) * 64 - qt * 128;
        const int qa = qoff[g];
        const bool skip = (qa - (kpos0 + 63) > 128) || (qa + 15 - kpos0 < -128);
        if (!skip) {
          const int qrel = qa + r16 - kpos0;
          auto mk = [qrel](int key, float s) {
            int d = qrel - key;
            return (d <= 128 && d >= -128) ? s : -1e30f;
          };
          attn_step<4>(Ksh, Vt, 0, aq[g], o[g], m[g], ls[g], mk, r16, quad);
        }
      } else {
        const int kr = R0 + vt;
        if (kr >= myR0 && kr < myR0 + 8) {
          const int qc = ((w & 1) * 2 + g) * 16 + r16;
          int qws = qc - 8; qws = qws < 0 ? 0 : (qws > 48 ? 48 : qws);
          const float* rbp = rpbs + (kr - myrow + 7) * 31 + 15 - qc;
          auto mk = [qws, rbp](int key, float s) {
            bool ok = (key >= qws) && (key < qws + 16);
            return ok ? (s + rbp[ok ? key : qws]) : -1e30f;
          };
          attn_step<2>(Ksh, Vt, kbeg[g], aq[g], o[g], m[g], ls[g], mk, r16, quad);
        }
      }
    }
  };
  issue(0, ak0, ak1, av0, av1);
  if (ntot > 1) issue(1, bk0, bk1, bv0, bv1);
#pragma unroll 1
  for (int vt = 0; vt < ntot; vt += 2) {
    __syncthreads();
    kv_commit_b(ak0, ak1, av0, av1, Ksh, Vt, tid);
    __syncthreads();
    if (vt + 2 < ntot) issue(vt + 2, ak0, ak1, av0, av1);
    do_step(vt);
    if (vt + 1 < ntot) {
      __syncthreads();
      kv_commit_b(bk0, bk1, bv0, bv1, Ksh, Vt, tid);
      __syncthreads();
      if (vt + 3 < ntot) issue(vt + 3, bk0, bk1, bv0, bv1);
      do_step(vt + 1);
    }
  }
#pragma unroll
  for (int g = 0; g < 2; ++g) {
    float tot = ls[g] + __shfl_xor(ls[g], 16);
    tot += __shfl_xor(tot, 32);
    float sc = 1.f;
    if (isA) {
      const float sk = p.sink[l * 4 + h] * LOG2E;
      const float mn = fmaxf(m[g], sk);
      const float al = fexp2(m[g] - mn);
      tot = tot * al + fexp2(sk - mn);
      sc = al;
    }
    const float inv = sc / tot;
    const int T = Tq0 + qoff[g] + r16;
#pragma unroll
    for (int n = 0; n < 4; ++n) {
      const int dv = n * 16 + quad * 4;
      const uint2 gg = gpre[g][n];
      uint2 ov;
      ov.x = pack2(o[g][n][0] * inv * silu_f(bflo(gg.x)), o[g][n][1] * inv * silu_f(bfhi(gg.x)));
      ov.y = pack2(o[g][n][2] * inv * silu_f(bflo(gg.y)), o[g][n][3] * inv * silu_f(bfhi(gg.y)));
      *reinterpret_cast<uint2*>(p.hbuf + (size_t)T * HS + mixcol + h * 64 + dv) = ov;
    }
  }
  __syncthreads();
}

__device__ void csum_item(const Params& p, int l, int it, unsigned char* smem) {
  u16* Ktf = (u16*)smem;
  u16* Ktb = Ktf + 64 * 72;
  u16* Vt = Ktb + 64 * 72;
  const int tid = otid(), w = tid >> 6, lane = tid & 63, r16 = lane & 15, quad = lane >> 4;
  const int c = it >> 2, h = it & 3, T0 = c * 64;
  const float lgf = ret_lg2(p, l, 0, h), lgb = ret_lg2(p, l, 1, h);
  __syncthreads();
  {
    const int dc = tid >> 5, kp = tid & 31, j0 = 2 * kp, j1 = j0 + 1;
    const u16* kb = p.proj + (size_t)(T0 + j0) * 4096 + 2048 + h * 64 + dc * 8;
    uint4 a = *reinterpret_cast<const uint4*>(kb);
    uint4 b = *reinterpret_cast<const uint4*>(kb + 4096);
    unsigned av[4] = {a.x, a.y, a.z, a.w}, bv[4] = {b.x, b.y, b.z, b.w};
    const float wf0 = 0.125f * fexp2(lgf * (float)(63 - j0)), wf1 = 0.125f * fexp2(lgf * (float)(63 - j1));
    const float wb0 = 0.125f * fexp2(lgb * (float)j0), wb1 = 0.125f * fexp2(lgb * (float)j1);
#pragma unroll
    for (int i = 0; i < 4; ++i) {
      float k0l = bflo(av[i]), k0h = bfhi(av[i]), k1l = bflo(bv[i]), k1h = bfhi(bv[i]);
      *reinterpret_cast<unsigned*>(Ktf + (dc * 8 + 2 * i) * 72 + j0) = pack2(k0l * wf0, k1l * wf1);
      *reinterpret_cast<unsigned*>(Ktf + (dc * 8 + 2 * i + 1) * 72 + j0) = pack2(k0h * wf0, k1h * wf1);
      *reinterpret_cast<unsigned*>(Ktb + (dc * 8 + 2 * i) * 72 + j0) = pack2(k0l * wb0, k1l * wb1);
      *reinterpret_cast<unsigned*>(Ktb + (dc * 8 + 2 * i + 1) * 72 + j0) = pack2(k0h * wb0, k1h * wb1);
    }
  }
  ld_tr_bf16(Vt, p.proj + (size_t)T0 * 4096 + 2304 + h * 64, 4096);
  __syncthreads();
#pragma unroll
  for (int dir = 0; dir < 2; ++dir) {
    const u16* Kt = dir ? Ktb : Ktf;
    f32x4 acc[4];
#pragma unroll
    for (int mt = 0; mt < 4; ++mt) acc[mt] = (f32x4){0.f, 0.f, 0.f, 0.f};
#pragma unroll
    for (int ks = 0; ks < 2; ++ks) {
      bf16x8 bv = ld8(Vt + (w * 16 + r16) * 72 + ks * 32 + quad * 8);
#pragma unroll
      for (int mt = 0; mt < 4; ++mt) acc[mt] = mfma16(ld8(Kt + (mt * 16 + r16) * 72 + ks * 32 + quad * 8), bv, acc[mt]);
    }
    u16* U = p.uc + (size_t)((c * 4 + h) * 2 + dir) * 4096 + (w * 16 + r16) * 64;
#pragma unroll
    for (int mt = 0; mt < 4; ++mt) {
      uint2 o;
      o.x = pack2(acc[mt][0], acc[mt][1]);
      o.y = pack2(acc[mt][2], acc[mt][3]);
      *reinterpret_cast<uint2*>(U + mt * 16 + quad * 4) = o;
    }
  }
  __syncthreads();
}

__device__ __forceinline__ void hgrn_gates(const uint4 a, const uint4 b, int dir, const float* lbs, float* Bc, float* kkf, u16* kkb, float* segtot) {
  const int tid = otid();
  {
    const int j = tid >> 2, part = (tid & 3) * 16;
    unsigned zz[8] = {a.x, a.y, a.z, a.w, b.x, b.y, b.z, b.w};
    float lfv[16], kfv[16];
#pragma unroll
    for (int i = 0; i < 16; ++i) {
      float z = (i & 1) ? bfhi(zz[i >> 1]) : bflo(zz[i >> 1]);
      float lb = fmaxf(lbs[dir * 64 + part + i], 1e-30f);
      float sneg = __builtin_amdgcn_rcpf(1.f + __expf(z));
      float spos = __builtin_amdgcn_rcpf(1.f + __expf(-z));
      kfv[i] = (1.f - lb) * sneg;
      float f = lb + (1.f - lb) * spos;
      lfv[i] = __log2f(fmaxf(f, 1e-30f));
    }
#pragma unroll
    for (int i = 0; i < 4; ++i) {
      *reinterpret_cast<float4*>(Bc + j * 68 + part + 4 * i) = make_float4(lfv[4 * i], lfv[4 * i + 1], lfv[4 * i + 2], lfv[4 * i + 3]);
      if (kkf) *reinterpret_cast<float4*>(kkf + j * 68 + part + 4 * i) = make_float4(kfv[4 * i], kfv[4 * i + 1], kfv[4 * i + 2], kfv[4 * i + 3]);
    }
    if (kkb) {
      uint4 o0, o1;
      o0.x = pack2(kfv[0], kfv[1]); o0.y = pack2(kfv[2], kfv[3]); o0.z = pack2(kfv[4], kfv[5]); o0.w = pack2(kfv[6], kfv[7]);
      o1.x = pack2(kfv[8], kfv[9]); o1.y = pack2(kfv[10], kfv[11]); o1.z = pack2(kfv[12], kfv[13]); o1.w = pack2(kfv[14], kfv[15]);
      *reinterpret_cast<uint4*>(kkb + j * 72 + part) = o0;
      *reinterpret_cast<uint4*>(kkb + j * 72 + part + 8) = o1;
    }
  }
  __syncthreads();
  const int ch = tid & 63, seg = tid >> 6;
  float v[16];
#pragma unroll
  for (int jj = 0; jj < 16; ++jj) v[jj] = Bc[(seg * 16 + jj) * 68 + ch];
  float tot;
  if (dir == 0) {
#pragma unroll
    for (int jj = 1; jj < 16; ++jj) v[jj] += v[jj - 1];
    tot = v[15];
  } else {
#pragma unroll
    for (int jj = 14; jj >= 0; --jj) v[jj] += v[jj + 1];
    tot = v[0];
  }
  segtot[seg * 64 + ch] = tot;
  __syncthreads();
  float off = 0.f;
#pragma unroll
  for (int s2 = 0; s2 < 4; ++s2) {
    const float t2 = segtot[s2 * 64 + ch];
    const bool use = dir ? (s2 > seg) : (s2 < seg);
    off += use ? t2 : 0.f;
  }
#pragma unroll
  for (int jj = 0; jj < 16; ++jj) Bc[(seg * 16 + jj) * 68 + ch] = v[jj] + off;
  __syncthreads();
}

__device__ void dsum_item(const Params& p, int l, int it, unsigned char* smem) {
  float* Bc = (float*)smem;
  float* kk = Bc + 64 * 68;
  u16* Kt = (u16*)(kk + 64 * 68);
  u16* Vt = Kt + 64 * 72;
  float* lbs = (float*)(Vt + 64 * 72);
  const int tid = otid(), w = tid >> 6, lane = tid & 63, r16 = lane & 15, quad = lane >> 4;
  const int c = it >> 2, h = it & 3, T0 = c * 64;
  __syncthreads();
  uint4 zf0, zf1, zb0, zb1;
  {
    const u16* zp = p.proj + (size_t)(T0 + (tid >> 2)) * 4096 + 3072 + h * 64 + (tid & 3) * 16;
    zf0 = *reinterpret_cast<const uint4*>(zp); zf1 = *reinterpret_cast<const uint4*>(zp + 8);
    zb0 = *reinterpret_cast<const uint4*>(zp + 256); zb1 = *reinterpret_cast<const uint4*>(zp + 264);
  }
  if (tid < 128) lbs[tid] = hgrn_lb(p, l, tid >> 6, h * 64 + (tid & 63));
  ld_tr_bf16(Vt, p.proj + (size_t)T0 * 4096 + 3584 + h * 64, 4096);
  __syncthreads();
#pragma unroll
  for (int dir = 0; dir < 2; ++dir) {
    hgrn_gates(dir ? zb0 : zf0, dir ? zb1 : zf1, dir, lbs, Bc, kk, nullptr, lbs + 128);
    const int lastj = dir ? 0 : 63;
    {
      const int j = tid >> 2, part = (tid & 3) * 16;
#pragma unroll
      for (int i4 = 0; i4 < 4; ++i4) {
        const int ch = part + 4 * i4;
        float4 kv4 = *reinterpret_cast<const float4*>(kk + j * 68 + ch);
        float4 bl = *reinterpret_cast<const float4*>(Bc + lastj * 68 + ch);
        float4 bj = *reinterpret_cast<const float4*>(Bc + j * 68 + ch);
        Kt[(ch + 0) * 72 + j] = f2bf(kv4.x * fexp2(bl.x - bj.x));
        Kt[(ch + 1) * 72 + j] = f2bf(kv4.y * fexp2(bl.y - bj.y));
        Kt[(ch + 2) * 72 + j] = f2bf(kv4.z * fexp2(bl.z - bj.z));
        Kt[(ch + 3) * 72 + j] = f2bf(kv4.w * fexp2(bl.w - bj.w));
      }
    }
    if (tid < 64) p.dg[(size_t)((c * 4 + h) * 2 + dir) * 64 + tid] = fexp2(Bc[lastj * 68 + tid]);
    __syncthreads();
    f32x4 acc[4];
#pragma unroll
    for (int mt = 0; mt < 4; ++mt) acc[mt] = (f32x4){0.f, 0.f, 0.f, 0.f};
#pragma unroll
    for (int ks = 0; ks < 2; ++ks) {
      bf16x8 bv = ld8(Vt + (w * 16 + r16) * 72 + ks * 32 + quad * 8);
#pragma unroll
      for (int mt = 0; mt < 4; ++mt) acc[mt] = mfma16(ld8(Kt + (mt * 16 + r16) * 72 + ks * 32 + quad * 8), bv, acc[mt]);
    }
    u16* U = p.ud + (size_t)((c * 4 + h) * 2 + dir) * 4096 + (w * 16 + r16) * 64;
#pragma unroll
    for (int mt = 0; mt < 4; ++mt) {
      uint2 o;
      o.x = pack2(acc[mt][0], acc[mt][1]);
      o.y = pack2(acc[mt][2], acc[mt][3]);
      *reinterpret_cast<uint2*>(U + mt * 16 + quad * 4) = o;
    }
    __syncthreads();
  }
}

template <int ISD, int NB>
__device__ __forceinline__ void scan_batch(u16* U, const float* dgp, int c0, int cstep, int h, int dir, int e, int dk, float dec,
                                           float& S0, float& S1, float& S2, float& S3) {
  unsigned u[NB], w2[NB];
  float2 d[NB];
#pragma unroll
  for (int i = 0; i < NB; ++i) {
    const int c = c0 + i * cstep;
    const size_t blk = (size_t)((c * 4 + h) * 2 + dir);
    u[i] = *reinterpret_cast<const unsigned*>(U + blk * 4096 + e);
    w2[i] = *reinterpret_cast<const unsigned*>(U + blk * 4096 + e + 2048);
    if (ISD) d[i] = *reinterpret_cast<const float2*>(dgp + blk * 64 + dk);
  }
#pragma unroll
  for (int i = 0; i < NB; ++i) {
    const int c = c0 + i * cstep;
    const size_t blk = (size_t)((c * 4 + h) * 2 + dir);
    *reinterpret_cast<unsigned*>(U + blk * 4096 + e) = pack2(S0, S1);
    *reinterpret_cast<unsigned*>(U + blk * 4096 + e + 2048) = pack2(S2, S3);
    const float d0 = ISD ? d[i].x : dec, d1 = ISD ? d[i].y : dec;
    S0 = S0 * d0 + bflo(u[i]);
    S1 = S1 * d1 + bfhi(u[i]);
    S2 = S2 * d0 + bflo(w2[i]);
    S3 = S3 * d1 + bfhi(w2[i]);
  }
}
template <int ISD>
__device__ void scan_item(const Params& p, int l, int it) {
  const int tid = otid();
  const int part = it & 3, dir = (it >> 2) & 1, h = (it >> 3) & 3, sidx = it >> 5;
  const int e = (part * 256 + tid) * 2, dv = e >> 6, dk = e & 63;
  const bool ctx = sidx < 16;
  const int nch = ctx ? 4 : 32;
  const int cb = ctx ? sidx * 4 : 64 + (sidx - 16) * 32;
  u16* U = ISD ? p.ud : p.uc;
  float dec = 0.f;
  if (!ISD) dec = fexp2(64.f * ret_lg2(p, l, dir, h));
  float S0 = 0.f, S1 = 0.f, S2 = 0.f, S3 = 0.f;
  if (!ctx) {
    const float* st = (ISD ? p.st_hgrn : p.st_ret) + (size_t)((((sidx - 16) * 4 + l) * 2 + dir) * 4 + h) * 4096;
    S0 = st[dk * 64 + dv];
    S1 = st[(dk + 1) * 64 + dv];
    S2 = st[dk * 64 + dv + 32];
    S3 = st[(dk + 1) * 64 + dv + 32];
  }
  const int cstart = dir ? (cb + nch - 1) : cb, cstep = dir ? -1 : 1;
  if (ctx) {
    scan_batch<ISD, 4>(U, p.dg, cstart, cstep, h, dir, e, dk, dec, S0, S1, S2, S3);
    float* os = p.out + (ISD ? OUT_SH : OUT_SR) + (size_t)(((sidx * 4 + l) * 2 + dir) * 4 + h) * 4096;
    os[dk * 64 + dv] = S0;
    os[(dk + 1) * 64 + dv] = S1;
    os[dk * 64 + dv + 32] = S2;
    os[(dk + 1) * 64 + dv + 32] = S3;
  } else {
    scan_batch<ISD, 16>(U, p.dg, cstart, cstep, h, dir, e, dk, dec, S0, S1, S2, S3);
    scan_batch<ISD, 16>(U, p.dg, cstart + 16 * cstep, cstep, h, dir, e, dk, dec, S0, S1, S2, S3);
  }
}

__device__ __forceinline__ void load_gate_rows(const Params& p, int Trow0, int gcol, int lane, uint4& g0, uint4& g1) {
  const int row = lane >> 2, c0 = (lane & 3) * 16;
  const u16* gp = p.proj + (size_t)(Trow0 + row) * 4096 + gcol + c0;
  g0 = *reinterpret_cast<const uint4*>(gp);
  g1 = *reinterpret_cast<const uint4*>(gp + 8);
}
__device__ __forceinline__ void store_rows_gated(const Params& p, float* stg  , const float (&val)[4][4],
                                                 int Trow0, const uint4 g0, const uint4 g1, int mcol, int lane) {
  const int r16 = lane & 15, quad = lane >> 4;
#pragma unroll
  for (int n = 0; n < 4; ++n)
#pragma unroll
    for (int j = 0; j < 4; ++j) stg[(quad * 4 + j) * 68 + n * 16 + r16] = val[n][j];
  wave_lds_sync();
  const int row = lane >> 2, c0 = (lane & 3) * 16;
  const int T = Trow0 + row;
  unsigned gw[8] = {g0.x, g0.y, g0.z, g0.w, g1.x, g1.y, g1.z, g1.w};
  unsigned ow[8];
#pragma unroll
  for (int i = 0; i < 4; ++i) {
    float4 v = *reinterpret_cast<const float4*>(stg + row * 68 + c0 + 4 * i);
    ow[2 * i] = pack2(v.x * silu_f(bflo(gw[2 * i])), v.y * silu_f(bfhi(gw[2 * i])));
    ow[2 * i + 1] = pack2(v.z * silu_f(bflo(gw[2 * i + 1])), v.w * silu_f(bfhi(gw[2 * i + 1])));
  }
  u16* op = p.hbuf + (size_t)T * HS + mcol + c0;
  *reinterpret_cast<uint4*>(op) = make_uint4(ow[0], ow[1], ow[2], ow[3]);
  *reinterpret_cast<uint4*>(op + 8) = make_uint4(ow[4], ow[5], ow[6], ow[7]);
}

__device__ void cout_item(const Params& p, int l, int it, unsigned char* smem) {
  u16* Qs = (u16*)smem;
  u16* Ks = Qs + 64 * 72;
  u16* Vt = Ks + 64 * 72;
  u16* SfT = Vt + 64 * 72;
  u16* SbT = SfT + 64 * 72;
  u16* Ps = SbT + 64 * 72;
  const int tid = otid(), w = tid >> 6, lane = tid & 63, r16 = lane & 15, quad = lane >> 4;
  const int c = it >> 2, h = it & 3, T0 = c * 64;
  const float lgf = ret_lg2(p, l, 0, h), lgb = ret_lg2(p, l, 1, h);
  uint4 gt0, gt1;
  load_gate_rows(p, T0 + w * 16, 2560 + h * 64, lane, gt0, gt1);
  __syncthreads();
  const u16* base = p.proj + (size_t)T0 * 4096;
  ld_rows_bf16(Qs, base + 1792 + h * 64, 4096);
  ld_rows_bf16(Ks, base + 2048 + h * 64, 4096);
  ld_tr_bf16(Vt, base + 2304 + h * 64, 4096);
  ld_rows_bf16(SfT, p.uc + (size_t)((c * 4 + h) * 2 + 0) * 4096, 64);
  ld_rows_bf16(SbT, p.uc + (size_t)((c * 4 + h) * 2 + 1) * 4096, 64);
  __syncthreads();
  const int i0 = w * 16;
  bf16x8 aq[2];
  aq[0] = ld8(Qs + (i0 + r16) * 72 + quad * 8);
  aq[1] = ld8(Qs + (i0 + r16) * 72 + 32 + quad * 8);
  f32x4 s[4];
#pragma unroll
  for (int nt = 0; nt < 4; ++nt) {
    s[nt] = (f32x4){0.f, 0.f, 0.f, 0.f};
#pragma unroll
    for (int ks = 0; ks < 2; ++ks) s[nt] = mfma16(aq[ks], ld8(Ks + (nt * 16 + r16) * 72 + ks * 32 + quad * 8), s[nt]);
  }
#pragma unroll
  for (int nt = 0; nt < 4; ++nt)
#pragma unroll
    for (int j = 0; j < 4; ++j) {
      const int i = i0 + quad * 4 + j, jj = nt * 16 + r16, d = i - jj;
      float wgt = (d > 0) ? fexp2(lgf * (float)d) : ((d < 0) ? fexp2(lgb * (float)(-d)) : 2.f);
      Ps[i * 72 + jj] = f2bf(s[nt][j] * 0.125f * wgt);
    }
  wave_lds_sync();
  f32x4 o[4], xf[4], xb[4];
#pragma unroll
  for (int n = 0; n < 4; ++n) { o[n] = (f32x4){0.f, 0.f, 0.f, 0.f}; xf[n] = o[n]; xb[n] = o[n]; }
#pragma unroll
  for (int ks = 0; ks < 2; ++ks) {
    bf16x8 ap = ld8(Ps + (i0 + r16) * 72 + ks * 32 + quad * 8);
#pragma unroll
    for (int n = 0; n < 4; ++n) {
      o[n] = mfma16(ap, ld8(Vt + (n * 16 + r16) * 72 + ks * 32 + quad * 8), o[n]);
      xf[n] = mfma16(aq[ks], ld8(SfT + (n * 16 + r16) * 72 + ks * 32 + quad * 8), xf[n]);
      xb[n] = mfma16(aq[ks], ld8(SbT + (n * 16 + r16) * 72 + ks * 32 + quad * 8), xb[n]);
    }
  }
  float val[4][4];
#pragma unroll
  for (int j = 0; j < 4; ++j) {
    const int i = i0 + quad * 4 + j;
    const float qf = fexp2(lgf * (float)(i + 1)), qb = fexp2(lgb * (float)(64 - i));
    float t[4], sum = 0.f;
#pragma unroll
    for (int n = 0; n < 4; ++n) { t[n] = o[n][j] + qf * xf[n][j] + qb * xb[n][j]; sum += t[n]; }
    const float mu = gsum16(sum) * (1.f / 64.f);
    float vs = 0.f;
#pragma unroll
    for (int n = 0; n < 4; ++n) { t[n] -= mu; vs += t[n] * t[n]; }
    const float rstd = rsqrtf(gsum16(vs) * (1.f / 64.f) + 1e-6f);
#pragma unroll
    for (int n = 0; n < 4; ++n) val[n][j] = t[n] * rstd;
  }
  __syncthreads();
  store_rows_gated(p, (float*)smem + w * (16 * 68), val, T0 + i0, gt0, gt1, 512 + h * 64, lane);
  __syncthreads();
}

__device__ void dout_item(const Params& p, int l, int it, unsigned char* smem) {
  u16* qs = (u16*)smem;
  u16* Vt = qs + 64 * 72;
  u16* kkb = Vt + 64 * 72;
  u16* Kt = kkb + 64 * 72;
  u16* ST = Kt + 64 * 72;
  u16* Ps = ST + 64 * 72;
  float* Bc = (float*)(Ps + 64 * 72);
  float* Rref = Bc + 64 * 68;
  float* lbs = Rref + 256;
  const int tid = otid(), w = tid >> 6, lane = tid & 63, r16 = lane & 15, quad = lane >> 4;
  const int c = it >> 2, h = it & 3, T0 = c * 64;
  uint4 gt0, gt1;
  load_gate_rows(p, T0 + w * 16, 3840 + h * 64, lane, gt0, gt1);
  uint4 zf0, zf1, zb0, zb1, sf0, sf1, sb0, sb1;
  {
    const int row = tid >> 2, part = (tid & 3) * 16;
    const u16* zp = p.proj + (size_t)(T0 + row) * 4096 + 3072 + h * 64 + part;
    zf0 = *reinterpret_cast<const uint4*>(zp); zf1 = *reinterpret_cast<const uint4*>(zp + 8);
    zb0 = *reinterpret_cast<const uint4*>(zp + 256); zb1 = *reinterpret_cast<const uint4*>(zp + 264);
    const u16* sp = p.ud + (size_t)((c * 4 + h) * 2) * 4096 + row * 64 + part;
    sf0 = *reinterpret_cast<const uint4*>(sp); sf1 = *reinterpret_cast<const uint4*>(sp + 8);
    sb0 = *reinterpret_cast<const uint4*>(sp + 4096); sb1 = *reinterpret_cast<const uint4*>(sp + 4096 + 8);
  }
  __syncthreads();
  if (tid < 128) lbs[tid] = hgrn_lb(p, l, tid >> 6, h * 64 + (tid & 63));
  {
    const int row = tid >> 2, part = (tid & 3) * 16;
    const u16* s = p.proj + (size_t)(T0 + row) * 4096 + 2816 + h * 64 + part;
    uint4 a = *reinterpret_cast<const uint4*>(s), b = *reinterpret_cast<const uint4*>(s + 8);
    unsigned zz[8] = {a.x, a.y, a.z, a.w, b.x, b.y, b.z, b.w};
#pragma unroll
    for (int i = 0; i < 8; ++i) zz[i] = pack2(silu_f(bflo(zz[i])), silu_f(bfhi(zz[i])));
    uint4 o0 = {zz[0], zz[1], zz[2], zz[3]}, o1 = {zz[4], zz[5], zz[6], zz[7]};
    *reinterpret_cast<uint4*>(qs + row * 72 + part) = o0;
    *reinterpret_cast<uint4*>(qs + row * 72 + part + 8) = o1;
  }
  ld_tr_bf16(Vt, p.proj + (size_t)T0 * 4096 + 3584 + h * 64, 4096);
  f32x4 o[4];
#pragma unroll
  for (int n = 0; n < 4; ++n) o[n] = (f32x4){0.f, 0.f, 0.f, 0.f};
  const int I = w;
#pragma unroll
  for (int dir = 0; dir < 2; ++dir) {
    __syncthreads();
    {
      const int row = tid >> 2, part = (tid & 3) * 16;
      *reinterpret_cast<uint4*>(ST + row * 72 + part) = dir ? sb0 : sf0;
      *reinterpret_cast<uint4*>(ST + row * 72 + part + 8) = dir ? sb1 : sf1;
    }
    hgrn_gates(dir ? zb0 : zf0, dir ? zb1 : zf1, dir, lbs, Bc, nullptr, kkb, Rref);
    Rref[tid] = Bc[((tid >> 6) * 16 + (dir ? 0 : 15)) * 68 + (tid & 63)];
    __syncthreads();
    {
      const int j = tid >> 2, part = (tid & 3) * 16;
      unsigned ov[8];
      uint4 kk0 = *reinterpret_cast<const uint4*>(kkb + j * 72 + part), kk1 = *reinterpret_cast<const uint4*>(kkb + j * 72 + part + 8);
      unsigned kw[8] = {kk0.x, kk0.y, kk0.z, kk0.w, kk1.x, kk1.y, kk1.z, kk1.w};
#pragma unroll
      for (int i4 = 0; i4 < 4; ++i4) {
        float4 rr = *reinterpret_cast<const float4*>(Rref + (j >> 4) * 64 + part + 4 * i4);
        float4 bb = *reinterpret_cast<const float4*>(Bc + j * 68 + part + 4 * i4);
        ov[2 * i4] = pack2(bflo(kw[2 * i4]) * fexp2(rr.x - bb.x), bfhi(kw[2 * i4]) * fexp2(rr.y - bb.y));
        ov[2 * i4 + 1] = pack2(bflo(kw[2 * i4 + 1]) * fexp2(rr.z - bb.z), bfhi(kw[2 * i4 + 1]) * fexp2(rr.w - bb.w));
      }
      uint4 o0 = {ov[0], ov[1], ov[2], ov[3]}, o1 = {ov[4], ov[5], ov[6], ov[7]};
      *reinterpret_cast<uint4*>(Kt + j * 72 + part) = o0;
      *reinterpret_cast<uint4*>(Kt + j * 72 + part + 8) = o1;
    }
    __syncthreads();
    f32x4 sacc[4];
#pragma unroll
    for (int J = 0; J < 4; ++J) sacc[J] = (f32x4){0.f, 0.f, 0.f, 0.f};
    const int irow = 16 * I + r16;
#pragma unroll
    for (int J = 0; J < 4; ++J) {
      const bool act = dir ? (J > I) : (J < I);
      if (act) {
#pragma unroll
        for (int ks = 0; ks < 2; ++ks) {
          const int ch0 = ks * 32 + quad * 8;
          uint4 qv = *reinterpret_cast<const uint4*>(qs + irow * 72 + ch0);
          unsigned qq[4] = {qv.x, qv.y, qv.z, qv.w};
          float4 b0 = *reinterpret_cast<const float4*>(Bc + irow * 68 + ch0), b1 = *reinterpret_cast<const float4*>(Bc + irow * 68 + ch0 + 4);
          float4 r0 = *reinterpret_cast<const float4*>(Rref + J * 64 + ch0), r1 = *reinterpret_cast<const float4*>(Rref + J * 64 + ch0 + 4);
          union { unsigned u[4]; bf16x8 v; } a;
          a.u[0] = pack2(bflo(qq[0]) * fexp2(b0.x - r0.x), bfhi(qq[0]) * fexp2(b0.y - r0.y));
          a.u[1] = pack2(bflo(qq[1]) * fexp2(b0.z - r0.z), bfhi(qq[1]) * fexp2(b0.w - r0.w));
          a.u[2] = pack2(bflo(qq[2]) * fexp2(b1.x - r1.x), bfhi(qq[2]) * fexp2(b1.y - r1.y));
          a.u[3] = pack2(bflo(qq[3]) * fexp2(b1.z - r1.z), bfhi(qq[3]) * fexp2(b1.w - r1.w));
          sacc[J] = mfma16(a.v, ld8(Kt + (16 * J + r16) * 72 + ch0), sacc[J]);
        }
      }
    }
#pragma unroll
    for (int J = 0; J < 4; ++J)
#pragma unroll
      for (int j = 0; j < 4; ++j) Ps[(16 * I + quad * 4 + j) * 72 + 16 * J + r16] = f2bf(sacc[J][j]);
    {
      const int rbase = 16 * I;
#pragma unroll 3
      for (int itq = 0; itq < 9; ++itq) {
        const int qp = itq * 64 + lane;
        const bool valid = qp < 544;
        const int pp = valid ? (qp >> 2) : 0, cq = qp & 3;
        int a2 = (int)((sqrtf(8.f * (float)pp + 1.f) - 1.f) * 0.5f);
        if ((a2 + 1) * (a2 + 2) / 2 <= pp) ++a2;
        if (a2 * (a2 + 1) / 2 > pp) --a2;
        const int b2 = pp - a2 * (a2 + 1) / 2;
        const int i = rbase + (dir ? b2 : a2), key = rbase + (dir ? a2 : b2);
        float sum = 0.f;
#pragma unroll
        for (int c8 = 0; c8 < 2; ++c8) {
          const int ch0 = cq * 16 + c8 * 8;
          uint4 kq = *reinterpret_cast<const uint4*>(kkb + key * 72 + ch0);
          unsigned kq4[4] = {kq.x, kq.y, kq.z, kq.w};
          float4 bk0 = *reinterpret_cast<const float4*>(Bc + key * 68 + ch0);
          float4 bk1 = *reinterpret_cast<const float4*>(Bc + key * 68 + ch0 + 4);
          float bk[8] = {bk0.x, bk0.y, bk0.z, bk0.w, bk1.x, bk1.y, bk1.z, bk1.w};
          uint4 qv = *reinterpret_cast<const uint4*>(qs + i * 72 + ch0);
          unsigned qq[4] = {qv.x, qv.y, qv.z, qv.w};
          float4 bi0 = *reinterpret_cast<const float4*>(Bc + i * 68 + ch0);
          float4 bi1 = *reinterpret_cast<const float4*>(Bc + i * 68 + ch0 + 4);
          float bi[8] = {bi0.x, bi0.y, bi0.z, bi0.w, bi1.x, bi1.y, bi1.z, bi1.w};
#pragma unroll
          for (int e2 = 0; e2 < 4; ++e2) {
            float w0 = fexp2(fminf(bi[2 * e2] - bk[2 * e2], 0.f));
            float w1 = fexp2(fminf(bi[2 * e2 + 1] - bk[2 * e2 + 1], 0.f));
            sum += bflo(qq[e2]) * bflo(kq4[e2]) * w0 + bfhi(qq[e2]) * bfhi(kq4[e2]) * w1;
          }
        }
        sum += DPPF(sum, 0xB1);
        sum += DPPF(sum, 0x4E);
        if (valid && cq == 0) Ps[i * 72 + key] = f2bf(sum);
      }
    }
    wave_lds_sync();
#pragma unroll
    for (int ks = 0; ks < 2; ++ks) {
      const int ch0 = ks * 32 + quad * 8;
      bf16x8 ap = ld8(Ps + irow * 72 + ch0);
      uint4 qv = *reinterpret_cast<const uint4*>(qs + irow * 72 + ch0);
      unsigned qq[4] = {qv.x, qv.y, qv.z, qv.w};
      float4 b0 = *reinterpret_cast<const float4*>(Bc + irow * 68 + ch0), b1 = *reinterpret_cast<const float4*>(Bc + irow * 68 + ch0 + 4);
      union { unsigned u[4]; bf16x8 v; } a;
      a.u[0] = pack2(bflo(qq[0]) * fexp2(b0.x), bfhi(qq[0]) * fexp2(b0.y));
      a.u[1] = pack2(bflo(qq[1]) * fexp2(b0.z), bfhi(qq[1]) * fexp2(b0.w));
      a.u[2] = pack2(bflo(qq[2]) * fexp2(b1.x), bfhi(qq[2]) * fexp2(b1.y));
      a.u[3] = pack2(bflo(qq[3]) * fexp2(b1.z), bfhi(qq[3]) * fexp2(b1.w));
#pragma unroll
      for (int n = 0; n < 4; ++n) {
        o[n] = mfma16(ap, ld8(Vt + (n * 16 + r16) * 72 + ch0), o[n]);
        o[n] = mfma16(a.v, ld8(ST + (n * 16 + r16) * 72 + ch0), o[n]);
      }
    }
  }
  float val[4][4];
#pragma unroll
  for (int j = 0; j < 4; ++j) {
    float ss = 0.f;
#pragma unroll
    for (int n = 0; n < 4; ++n) ss += o[n][j] * o[n][j];
    const float rstd = rsqrtf(gsum16(ss) * (1.f / 64.f) + 1e-6f);
#pragma unroll
    for (int n = 0; n < 4; ++n) val[n][j] = o[n][j] * rstd;
  }
  __syncthreads();
  store_rows_gated(p, (float*)smem + w * (16 * 68), val, T0 + 16 * I, gt0, gt1, 768 + h * 64, lane);
  __syncthreads();
}

#define XB_TMO      128
#define XB_XCNT(j)  (256  + 64 * (j))
#define XB_XSUB(j)  (1280 + 64 * (j))
#define XB_XGEN(j)  (2304 + 64 * (j))
#define XB_TOP      3328
#define XB_TOPGEN   3392
#define XCD_BAR_WORDS 3456
#define XB_SPIN_CAP (1u << 18)
#define LAS __attribute__((address_space(3)))
__device__ __forceinline__ unsigned xb_ld(unsigned* p)              { return __hip_atomic_load(p, __ATOMIC_RELAXED, __HIP_MEMORY_SCOPE_AGENT); }
__device__ __forceinline__ unsigned xb_add(unsigned* p, unsigned v) { return __hip_atomic_fetch_add(p, v, __ATOMIC_RELAXED, __HIP_MEMORY_SCOPE_AGENT); }
__device__ __forceinline__ unsigned xb_xcc_id() { return (unsigned)__builtin_amdgcn_s_getreg((3 << 11) | 20) & 0xFu; }
#define XB_SPIN(cond, bar) do { unsigned _sp = 0; while (cond) { __builtin_amdgcn_s_sleep(1); \
    if ((++_sp & 255u) == 0u) { if (xb_ld(&(bar)[XB_TMO])) break; if (_sp > XB_SPIN_CAP) { atomicAdd(&(bar)[XB_TMO], 1u); break; } } } } while (0)
struct XcdBarrier { unsigned* bar; unsigned x; volatile LAS unsigned* st; };
__device__ __forceinline__ XcdBarrier xcd_barrier_post(unsigned* bar, volatile LAS unsigned* st) {
    XcdBarrier b; b.bar = bar; b.x = xb_xcc_id(); b.st = st;
    if (threadIdx.x == 0) (void)xb_add(&bar[XB_XCNT(b.x)], 1u);
    return b;
}
__device__ __forceinline__ void xcd_barrier_complete(unsigned* bar, unsigned x, unsigned& nloc, unsigned& nx) {
    const unsigned G = gridDim.x * gridDim.y * gridDim.z;
    unsigned sum, cnt, mine, sp = 0u;
    for (;;) {
        sum = 0u; cnt = 0u; mine = 0u;
#pragma unroll
        for (unsigned j = 0; j < 16; ++j) { const unsigned c = xb_ld(&bar[XB_XCNT(j)]); sum += c; cnt += (c > 0u) ? 1u : 0u; mine = (j == x) ? c : mine; }
        if (sum == G) break;
        __builtin_amdgcn_s_sleep(1);
        if ((++sp & 255u) == 0u) { if (xb_ld(&bar[XB_TMO])) break; if (sp > XB_SPIN_CAP) { atomicAdd(&bar[XB_TMO], 1u); break; } }
    }
    nloc = mine > 0u ? mine : 1u; nx = cnt > 0u ? cnt : 1u;
}
__device__ __forceinline__ void xcd_barrier(const XcdBarrier& b) {
    asm volatile("s_waitcnt vmcnt(0)" ::: "memory");
    __syncthreads();
    if (threadIdx.x == 0) {
        unsigned* bar = b.bar;
        __builtin_amdgcn_s_waitcnt(0);
        unsigned nloc = b.st[0], nx = b.st[1];
        if (nloc == 0u) { xcd_barrier_complete(bar, b.x, nloc, nx); b.st[0] = nloc; b.st[1] = nx; }
        const unsigned old = xb_add(&bar[XB_XSUB(b.x)], 1u);
        const unsigned gen = old / nloc;
        if (old + 1u == (gen + 1u) * nloc) {
            __builtin_amdgcn_fence(__ATOMIC_RELEASE, "agent");
            asm volatile("s_waitcnt vmcnt(0)" ::: "memory");
            const unsigned og = xb_add(&bar[XB_TOP], 1u);
            const unsigned tg = og / nx;
            if (og + 1u == (tg + 1u) * nx) xb_add(&bar[XB_TOPGEN], 1u);
            else XB_SPIN(xb_ld(&bar[XB_TOPGEN]) == tg, bar);
            __builtin_amdgcn_fence(__ATOMIC_ACQUIRE, "agent");
            xb_add(&bar[XB_XGEN(b.x)], 1u);
            asm volatile("s_waitcnt vmcnt(0)" ::: "memory");
        } else {
            XB_SPIN(xb_ld(&bar[XB_XGEN(b.x)]) == gen, bar);
            __builtin_amdgcn_fence(__ATOMIC_ACQUIRE, "agent");
            asm volatile("s_waitcnt vmcnt(0)" ::: "memory");
        }
    }
    __syncthreads();
}

__global__ void __launch_bounds__(256, 2) mega(Params p) {
  extern __shared__ __attribute__((aligned(16))) unsigned char smem[];
  const int nb = gridDim.x, bid = blockIdx.x;
  volatile LAS unsigned* xst = (volatile LAS unsigned*)(smem + LDS_BYTES - 16);
  if (threadIdx.x == 0) { xst[0] = 0u; xst[1] = 0u; xst[2] = 0u; xst[3] = 0u; }
  __syncthreads();
  XcdBarrier xb = xcd_barrier_post(p.bar, xst);
#pragma unroll 1
  for (int it = bid; it < 192 + 256 + 1024 + 256; it += nb) {
    if (it < 192) adaln_item(p, it, smem);
    else if (it < 448) rope_item(p, it - 192);
    else if (it < 1472) conv_tile(p.w_in, 4096, p.wt_in, it - 448, smem);
    else conv_tile(p.w_out, 1024, p.wt_out, it - 1472, smem);
  }
  xcd_barrier(xb);
#pragma unroll 1
  for (int l = 0; l < 4; ++l) {
#pragma unroll 1
    for (int rep = 0; rep < REP_P1 - 1; ++rep) prep_phase<1>(p, l, bid, nb);
    prep_phase<0>(p, l, bid, nb);
    {
      const int n = (l > 0 ? 256 : 0);
#pragma unroll 1
      for (int it = bid; it < n; it += nb) conv_tile(p.w_out + (size_t)l * 1024 * 1024, 1024, p.wt_out, it, smem);
    }
    xcd_barrier(xb);
#pragma unroll 1
    for (int rep = 0; rep < REP_P2; ++rep)
#pragma unroll 1
    for (int it = bid; it < 2560; it += nb) gemm_big(p, l, it, smem);
    xcd_barrier(xb);
    for (int e = 0; e < EXTRA_SYNC; ++e) xcd_barrier(xb);
    {
      const int n = 128 + 128 + 1280 + 1280;
#pragma unroll 1
      for (int rep = 0; rep < REP_P3A; ++rep)
#pragma unroll 1
      for (int it = bid; it < n; it += nb) {
        if (it < 128) attn_item<0>(p, l, it, smem);
        else if (it < 256) attn_item<1>(p, l, it - 128, smem);
        else if (it < 1536) dsum_item(p, l, it - 256, smem);
        else csum_item(p, l, it - 1536, smem);
      }
      if (bid >= (nb >> 1)) {
        const int hb = nb - (nb >> 1);
#pragma unroll 1
        for (int ci = bid - (nb >> 1); ci < 768; ci += hb) cache_conv_item(p, l, ci);
      }
    }
    xcd_barrier(xb);
    {
      const int n = 512 + 512 + 768 + 768;
#pragma unroll 1
      for (int rep = 0; rep < REP_P3B - 1; ++rep)
#pragma unroll 1
      for (int it = bid; it < 1024; it += nb) {
        if (it < 512) attn_item<2>(p, l, it, smem);
        else attn_item<3>(p, l, it - 512, smem);
      }
#pragma unroll 1
      for (int it = bid; it < n; it += nb) {
        if (it < 512) attn_item<2>(p, l, it, smem);
        else if (it < 1024) attn_item<3>(p, l, it - 512, smem);
        else if (it < 1792) scan_item<0>(p, l, it - 1024);
        else scan_item<1>(p, l, it - 1792);
      }
    }
    xcd_barrier(xb);
#pragma unroll 1
    for (int rep = 0; rep < REP_P3C; ++rep)
#pragma unroll 1
    for (int it = bid; it < 2560; it += nb) {
      if (it < 1280) dout_item(p, l, it, smem);
      else cout_item(p, l, it - 1280, smem);
    }
    if (l < 3 && bid >= (nb >> 1)) {
      const int hb = nb - (nb >> 1);
#pragma unroll 1
      for (int ci = bid - (nb >> 1); ci < 1024; ci += hb) conv_tile(p.w_in + (size_t)(l + 1) * 1024 * 4096, 4096, p.wt_in, ci, smem);
    }
    xcd_barrier(xb);
#pragma unroll 1
    for (int rep = 0; rep < REP_P4; ++rep)
#pragma unroll 1
    for (int it = bid; it < 1024; it += nb) gemm_out(p, it, smem);
    xcd_barrier(xb);
  }
  prep_phase<0>(p, 4, bid, nb);
}

extern "C" void kernel_launch(void* const* d_in, const int* in_sizes, int n_in, void* d_out, int out_size, void* d_ws,
                              size_t ws_size, hipStream_t stream) {
  static int grid_blocks = 0;
  if (!grid_blocks) {
    int dev = 0, cus = 0, per_cu = 0;
    hipGetDevice(&dev);
    hipDeviceGetAttribute(&cus, hipDeviceAttributeMultiprocessorCount, dev);
    hipFuncSetAttribute((const void*)mega, hipFuncAttributeMaxDynamicSharedMemorySize, LDS_BYTES);
    hipOccupancyMaxActiveBlocksPerMultiprocessor(&per_cu, (const void*)mega, 256, LDS_BYTES);
    if (per_cu < 1) per_cu = 1;
    if (per_cu > 2) per_cu = 2;
    grid_blocks = cus * per_cu;
  }
  Params p{};
  const float* const* in = (const float* const*)d_in;
  p.x_prompt = in[0]; p.x_sample = in[1]; p.c = in[2]; p.cwk = in[3]; p.cwv = in[4]; p.cnk = in[5]; p.cnv = in[6];
  p.st_ret = in[7]; p.st_hgrn = in[8]; p.c_ctx = in[9]; p.w_ada = in[10]; p.b_ada = in[11]; p.g_pre = in[12];
  p.g_post = in[13]; p.w_in = in[14]; p.w_out = in[15]; p.sink = in[16]; p.rpb = in[17]; p.ret_logit = in[18];
  p.lb_logit = in[19];
  p.out = (float*)d_out;
  unsigned char* ws = (unsigned char*)d_ws;
  size_t off = 0;
  p.wt_in = (u16*)(ws + off); off += (size_t)4096 * WS * 2;
  p.wt_out = (u16*)(ws + off); off += (size_t)1024 * WS * 2;
  p.hbuf = (u16*)(ws + off); off += (size_t)NTOK * HS * 2;
  p.proj = (u16*)(ws + off); p.ybuf = (u16*)(ws + off); off += (size_t)NTOK * 4096 * 2;
  p.uc = (u16*)(ws + off); off += (size_t)320 * 4 * 2 * 4096 * 2;
  p.ud = (u16*)(ws + off); off += (size_t)320 * 4 * 2 * 4096 * 2;
  p.dg = (float*)(ws + off); off += (size_t)320 * 4 * 2 * 64 * 4;
  p.mod = (float*)(ws + off); off += (size_t)4 * 9 * 3072 * 4;
  p.rope = (float*)(ws + off); off += (size_t)2048 * 32 * 2 * 4;
  p.bar = (unsigned*)(ws + off); off += (size_t)XCD_BAR_WORDS * 4;
  off = (off + 255) & ~(size_t)255;
  p.cbak = (u16*)(ws + off); off += (size_t)8 * 256 * 128 * 2;
  p.cbav = (u16*)(ws + off); off += (size_t)8 * 256 * 128 * 2;
  p.cbbk = (u16*)(ws + off); off += (size_t)8 * 256 * 256 * 2;
  p.cbbv = (u16*)(ws + off); off += (size_t)8 * 256 * 256 * 2;
  if (off > ws_size) { fprintf(stderr, "workspace too small: need %zu have %zu\n", off, ws_size); return; }
  if (hipMemsetAsync(p.bar, 0, (size_t)XCD_BAR_WORDS * 4, stream) != hipSuccess) { fprintf(stderr, "memset failed\n"); return; }
  void* args[] = {&p};
  hipError_t e = hipLaunchCooperativeKernel((const void*)mega, dim3(grid_blocks), dim3(256), args, LDS_BYTES, stream);
  if (e != hipSuccess) fprintf(stderr, "cooperative launch failed: %s (grid %d)\n", hipGetErrorString(e), grid_blocks);
}
```

```cpp
#include <hip/hip_runtime.h>
#include <hip/hip_cooperative_groups.h>
#include <cstdio>
#include <cstdint>
namespace cg = cooperative_groups;

typedef unsigned short u16;
typedef __attribute__((ext_vector_type(8))) short bf16x8;
typedef __attribute__((ext_vector_type(4))) float f32x4;

#define LOG2E 1.4426950408889634f
#define NTOK 20480
#define NCTX 4096
#define LDS_BYTES 75776
#define HS 1024
#define WS 1024
#ifndef REP_P1
#define REP_P1 1
#endif
#ifndef REP_SCAN
#define REP_SCAN 1
#endif
#ifndef REP_P2
#define REP_P2 1
#endif
#ifndef REP_P3A
#define REP_P3A 1
#endif
#ifndef REP_P3B
#define REP_P3B 1
#endif
#ifndef REP_P3C
#define REP_P3C 1
#endif
#ifndef REP_P4
#define REP_P4 1
#endif
#ifndef EXTRA_SYNC
#define EXTRA_SYNC 0
#endif

struct Params {
  const float *x_prompt, *x_sample, *c, *cwk, *cwv, *cnk, *cnv, *st_ret, *st_hgrn, *c_ctx,
      *w_ada, *b_ada, *g_pre, *g_post, *w_in, *w_out, *sink, *rpb, *ret_logit, *lb_logit;
  float* out;
  u16 *wt_in, *wt_out, *hbuf, *proj, *uc, *ud;
  float *dg, *mod, *rope;
  u16* ybuf;
  unsigned* bar;
  u16 *cbak, *cbav, *cbbk, *cbbv;
};

#define OUT_WK 20971520
#define OUT_WV 23068672
#define OUT_NK 25165824
#define OUT_NV 29360128
#define OUT_SR 33554432
#define OUT_SH 35651584

__device__ __forceinline__ int otid() { int t = threadIdx.x; asm volatile("" : "+v"(t)); return t; }
typedef __bf16 bf2_t __attribute__((ext_vector_type(2)));
__device__ __forceinline__ unsigned pack2(float a, float b) { bf2_t v; v[0] = (__bf16)a; v[1] = (__bf16)b; return __builtin_bit_cast(unsigned, v); }
__device__ __forceinline__ u16 f2bf(float f) { return (u16)(pack2(f, 0.f) & 0xffffu); }
__device__ __forceinline__ float bf2f(u16 h) { return __uint_as_float(((unsigned)h) << 16); }
__device__ __forceinline__ float bflo(unsigned u) { return __uint_as_float(u << 16); }
__device__ __forceinline__ float bfhi(unsigned u) { return __uint_as_float(u & 0xffff0000u); }
__device__ __forceinline__ float fexp2(float x) { return __builtin_amdgcn_exp2f(x); }
__device__ __forceinline__ float silu_f(float x) { return x / (1.f + __expf(-x)); }
__device__ __forceinline__ float wsum64(float v) {
#pragma unroll
  for (int o = 32; o >= 1; o >>= 1) v += __shfl_xor(v, o);
  return v;
}
#define DPPF(v, ctrl) __int_as_float(__builtin_amdgcn_update_dpp(0, __float_as_int(v), ctrl, 0xF, 0xF, true))
__device__ __forceinline__ float gsum16(float v) {
  v += DPPF(v, 0xB1); v += DPPF(v, 0x4E); v += DPPF(v, 0x141); v += DPPF(v, 0x140);
  return v;
}
__device__ __forceinline__ float gmax16(float v) {
  v = fmaxf(v, DPPF(v, 0xB1)); v = fmaxf(v, DPPF(v, 0x4E)); v = fmaxf(v, DPPF(v, 0x141)); v = fmaxf(v, DPPF(v, 0x140));
  return v;
}
__device__ __forceinline__ void wave_lds_sync() {
  __builtin_amdgcn_fence(__ATOMIC_RELEASE, "workgroup");
  __builtin_amdgcn_wave_barrier();
  __builtin_amdgcn_fence(__ATOMIC_ACQUIRE, "workgroup");
}
__device__ __forceinline__ f32x4 mfma16(bf16x8 a, bf16x8 b, f32x4 c) {
  return __builtin_amdgcn_mfma_f32_16x16x32_bf16(a, b, c, 0, 0, 0);
}
__device__ __forceinline__ bf16x8 ld8(const u16* p) { return *reinterpret_cast<const bf16x8*>(p); }

__device__ __forceinline__ float ret_lg2(const Params& p, int l, int dir, int h) {
  float x = p.ret_logit[(l * 2 + dir) * 4 + h];
  return -log1pf(expf(-x)) * LOG2E;
}
__device__ __forceinline__ float hgrn_lb(const Params& p, int l, int dir, int ch256) {
  float a0 = p.lb_logit[(0 * 2 + dir) * 256 + ch256], a1 = p.lb_logit[(1 * 2 + dir) * 256 + ch256];
  float a2 = p.lb_logit[(2 * 2 + dir) * 256 + ch256], a3 = p.lb_logit[(3 * 2 + dir) * 256 + ch256];
  float mx = fmaxf(fmaxf(a0, a1), fmaxf(a2, a3));
  float e0 = expf(a0 - mx), e1 = expf(a1 - mx), e2 = expf(a2 - mx), e3 = expf(a3 - mx);
  float inv = 1.f / (e0 + e1 + e2 + e3);
  float s = 0.f;
  if (l >= 1) s += e1;
  if (l >= 2) s += e2;
  if (l >= 3) s += e3;
  return s * inv;
}

__device__ void adaln_item(const Params& p, int it, unsigned char* smem) {
  float* sv = (float*)smem;
  float* red = sv + 9 * 1024;
  const int tid = otid(), w = tid >> 6, lane = tid & 63;
  const int l = it / 48, cb = (it % 48) * 64;
  __syncthreads();
  for (int i = tid; i < 9 * 1024; i += 256) {
    int v = i >> 10, k = i & 1023;
    float cv = v < 8 ? p.c[v * 1024 + k] : p.c_ctx[k];
    sv[i] = cv / (1.f + expf(-cv));
  }
  __syncthreads();
  const int col = cb + lane;
  const float* W = p.w_ada + (size_t)l * 1024 * 3072 + col;
  float acc[9];
#pragma unroll
  for (int v = 0; v < 9; ++v) acc[v] = 0.f;
#pragma unroll 1
  for (int k0 = w * 256; k0 < w * 256 + 256; k0 += 16) {
    float wv[16];
#pragma unroll
    for (int i = 0; i < 16; ++i) wv[i] = W[(size_t)(k0 + i) * 3072];
#pragma unroll
    for (int i = 0; i < 16; ++i)
#pragma unroll
      for (int v = 0; v < 9; ++v) acc[v] += sv[v * 1024 + k0 + i] * wv[i];
  }
#pragma unroll
  for (int v = 0; v < 9; ++v) red[(w * 9 + v) * 64 + lane] = acc[v];
  __syncthreads();
  if (tid < 64) {
    float bb = p.b_ada[l * 3072 + col];
#pragma unroll
    for (int v = 0; v < 9; ++v) {
      float s = red[(0 * 9 + v) * 64 + lane] + red[(1 * 9 + v) * 64 + lane] + red[(2 * 9 + v) * 64 + lane] + red[(3 * 9 + v) * 64 + lane];
      p.mod[(l * 9 + v) * 3072 + col] = s + bb;
    }
  }
  __syncthreads();
}

__device__ void rope_item(const Params& p, int it) {
  int idx = it * 256 + otid();
  int s = idx >> 5, i = idx & 31, fi = i & 15;
  float freq = powf(10000.f, -(float)fi / 16.f);
  int pos = (i < 16) ? (s >> 6) : (s & 63);
  float ang = (float)pos * freq;
  p.rope[idx * 2] = cosf(ang);
  p.rope[idx * 2 + 1] = sinf(ang);
}

__device__ void conv_tile(const float* src, int N, u16* dst, int tile, unsigned char* smem) {
  float* t = (float*)smem;
  const int tid = otid();
  const int ntn = N >> 6;
  const int k0 = (tile / ntn) * 64, n0 = (tile % ntn) * 64;
  __syncthreads();
#pragma unroll
  for (int r = 0; r < 16; ++r) {
    int row = r * 4 + (tid >> 6), col = tid & 63;
    t[row * 65 + col] = src[(size_t)(k0 + row) * N + n0 + col];
  }
  __syncthreads();
#pragma unroll
  for (int r = 0; r < 8; ++r) {
    int n = r * 8 + (tid >> 5), kp = tid & 31;
    unsigned v = pack2(t[(2 * kp) * 65 + n], t[(2 * kp + 1) * 65 + n]);
    *reinterpret_cast<unsigned*>(dst + (size_t)(n0 + n) * WS + k0 + 2 * kp) = v;
  }
  __syncthreads();
}


__device__ void cache_conv_item(const Params& p, int l, int it) {
  const int tid = otid();
  const float* src; u16* dst; int W, e0;
  if (it < 128) { src = p.cwk; dst = p.cbak; W = 128; e0 = it * 2048; }
  else if (it < 256) { src = p.cwv; dst = p.cbav; W = 128; e0 = (it - 128) * 2048; }
  else if (it < 512) { src = p.cnk; dst = p.cbbk; W = 256; e0 = (it - 256) * 2048; }
  else { src = p.cnv; dst = p.cbbv; W = 256; e0 = (it - 512) * 2048; }
  const int e = e0 + tid * 8;
  const int per_b = 256 * W, b = e / per_b, r = e - b * per_b;
  const float* sp = src + (size_t)((b * 4 + l) * 256) * W + r;
  float4 a = *reinterpret_cast<const float4*>(sp), c = *reinterpret_cast<const float4*>(sp + 4);
  uint4 o;
  o.x = pack2(a.x, a.y); o.y = pack2(a.z, a.w); o.z = pack2(c.x, c.y); o.w = pack2(c.z, c.w);
  *reinterpret_cast<uint4*>(dst + e) = o;
}
struct PrepRow { float4 x[4]; uint2 y[4]; float4 g[4], sh[4], sc[4]; };
__device__ __forceinline__ void prep_issue(const Params& p, int l, int T, int lane, PrepRow& r) {
  const int v = T < NCTX ? 8 : ((T - NCTX) >> 11);
  const float* xin = (l <= 1) ? (T < NCTX ? p.x_prompt + (size_t)T * 1024 : p.x_sample + (size_t)(T - NCTX) * 1024)
                              : p.out + (size_t)T * 1024;
#pragma unroll
  for (int i = 0; i < 4; ++i) r.x[i] = *reinterpret_cast<const float4*>(xin + (i * 64 + lane) * 4);
  if (l > 0) {
    const u16* yr = p.ybuf + (size_t)T * 1024;
    const float* gate = p.mod + ((l - 1) * 9 + v) * 3072 + 2048;
#pragma unroll
    for (int i = 0; i < 4; ++i) {
      const int col = (i * 64 + lane) * 4;
      r.y[i] = *reinterpret_cast<const uint2*>(yr + col);
      r.g[i] = *reinterpret_cast<const float4*>(gate + col);
    }
  }
  if (l < 4) {
    const float* md = p.mod + (l * 9 + v) * 3072;
#pragma unroll
    for (int i = 0; i < 4; ++i) {
      const int col = (i * 64 + lane) * 4;
      r.sh[i] = *reinterpret_cast<const float4*>(md + col);
      r.sc[i] = *reinterpret_cast<const float4*>(md + 1024 + col);
    }
  }
}
template <int DRY>
__device__ void prep_phase(const Params& p, int l, int bid, int nb) {
  const int tid = otid(), w = tid >> 6, lane = tid & 63;
  const int tstep = nb * 4;
  int T = bid * 4 + w;
  if (T >= NTOK) return;
  float4 pq[4], pgp[4];
#pragma unroll
  for (int i = 0; i < 4; ++i) {
    const int col = (i * 64 + lane) * 4;
    if (l > 0) pq[i] = *reinterpret_cast<const float4*>(p.g_post + (l - 1) * 1024 + col);
    if (l < 4) pgp[i] = *reinterpret_cast<const float4*>(p.g_pre + l * 1024 + col);
  }
  PrepRow cur, nxt;
  prep_issue(p, l, T, lane, nxt);
#pragma unroll 1
  for (; T < NTOK; T += tstep) {
    cur = nxt;
    if (T + tstep < NTOK) prep_issue(p, l, T + tstep, lane, nxt);
    float4 xv[4];
#pragma unroll
    for (int i = 0; i < 4; ++i) xv[i] = cur.x[i];
    if (l > 0) {
      float4 yv[4];
      float ss = 0.f;
#pragma unroll
      for (int i = 0; i < 4; ++i) {
        yv[i] = make_float4(bflo(cur.y[i].x), bfhi(cur.y[i].x), bflo(cur.y[i].y), bfhi(cur.y[i].y));
        ss += yv[i].x * yv[i].x + yv[i].y * yv[i].y + yv[i].z * yv[i].z + yv[i].w * yv[i].w;
      }
      ss = wsum64(ss);
      const float rstd = rsqrtf(ss * (1.f / 1024.f) + 1e-6f);
#pragma unroll
      for (int i = 0; i < 4; ++i) {
        const int col = (i * 64 + lane) * 4;
        xv[i].x += cur.g[i].x * (yv[i].x * rstd * pq[i].x);
        xv[i].y += cur.g[i].y * (yv[i].y * rstd * pq[i].y);
        xv[i].z += cur.g[i].z * (yv[i].z * rstd * pq[i].z);
        xv[i].w += cur.g[i].w * (yv[i].w * rstd * pq[i].w);
        if (!DRY) *reinterpret_cast<float4*>(p.out + (size_t)T * 1024 + col) = xv[i];
      }
    }
    if (l < 4) {
      float ss = 0.f;
#pragma unroll
      for (int i = 0; i < 4; ++i) ss += xv[i].x * xv[i].x + xv[i].y * xv[i].y + xv[i].z * xv[i].z + xv[i].w * xv[i].w;
      ss = wsum64(ss);
      const float rstd = rsqrtf(ss * (1.f / 1024.f) + 1e-6f);
#pragma unroll
      for (int i = 0; i < 4; ++i) {
        const int col = (i * 64 + lane) * 4;
        const float h0 = xv[i].x * rstd * pgp[i].x * (1.f + cur.sc[i].x) + cur.sh[i].x;
        const float h1 = xv[i].y * rstd * pgp[i].y * (1.f + cur.sc[i].y) + cur.sh[i].y;
        const float h2 = xv[i].z * rstd * pgp[i].z * (1.f + cur.sc[i].z) + cur.sh[i].z;
        const float h3 = xv[i].w * rstd * pgp[i].w * (1.f + cur.sc[i].w) + cur.sh[i].w;
        uint2 o;
        o.x = pack2(h0, h1);
        o.y = pack2(h2, h3);
        *reinterpret_cast<uint2*>(p.hbuf + (size_t)T * HS + col) = o;
      }
    }
  }
}

template <int MODE>
__device__ void gemm_tile(const Params& p, int l, int tile, unsigned char* smem) {
  u16* As = (u16*)smem;
  u16* Bs = As + 128 * 72;
  const int tid = otid(), w = tid >> 6, lane = tid & 63, r16 = lane & 15, quad = lane >> 4;
  const int wr = w >> 1, wc = w & 1;
  const int ntn = (MODE == 0) ? 32 : 8;
  const int ntm = (MODE == 0) ? 160 : 160;
  const int tm = tile % ntm, tn = tile / ntm;
  const u16* Agp = p.hbuf + (size_t)(tm * 128) * HS;
  const u16* Bgp = ((MODE == 0) ? p.wt_in : p.wt_out) + (size_t)(tn * 128) * WS;
  f32x4 acc[4][4];
#pragma unroll
  for (int a = 0; a < 4; ++a)
#pragma unroll
    for (int b = 0; b < 4; ++b) acc[a][b] = (f32x4){0.f, 0.f, 0.f, 0.f};
  const int lrow = tid >> 3, lkc = (tid & 7) * 8;
  const unsigned voff_Agp = lrow * HS + lkc, voff_Bgp = lrow * WS + lkc;
  u16* Asp = As + lrow * 72 + lkc;
  u16* Bsp = Bs + lrow * 72 + lkc;
  uint4 ra0, ra1, ra2, ra3, rb0, rb1, rb2, rb3;
#define GLD(p_, r_, S_) *reinterpret_cast<const uint4*>((p_) + ((size_t)(r_) * 32 * S_ + kofs) + voff_##p_)
#define GLOAD(KO) { const int kofs = (KO); \
  ra0 = GLD(Agp, 0, HS); ra1 = GLD(Agp, 1, HS); ra2 = GLD(Agp, 2, HS); ra3 = GLD(Agp, 3, HS); \
  rb0 = GLD(Bgp, 0, WS); rb1 = GLD(Bgp, 1, WS); rb2 = GLD(Bgp, 2, WS); rb3 = GLD(Bgp, 3, WS); }
#define SST(p_, st_, r_, v_) *reinterpret_cast<uint4*>((p_) + (st_) * (2 * 128 * 72) + (r_) * 32 * 72) = v_
#define STORE(st_) { SST(Asp, st_, 0, ra0); SST(Asp, st_, 1, ra1); SST(Asp, st_, 2, ra2); SST(Asp, st_, 3, ra3); \
                     SST(Bsp, st_, 0, rb0); SST(Bsp, st_, 1, rb1); SST(Bsp, st_, 2, rb2); SST(Bsp, st_, 3, rb3); }
  __syncthreads();
  GLOAD(0)
  STORE(0)
  GLOAD(64)
  __syncthreads();
#pragma unroll 1
  for (int kt = 0; kt < 16; ++kt) {
    const int cur = kt & 1;
    if (kt + 1 < 16) STORE(cur ^ 1)
    if (kt + 2 < 16) GLOAD((kt + 2) * 64)
    const u16* Ac = As + cur * (2 * 128 * 72);
    const u16* Bc = Bs + cur * (2 * 128 * 72);
    __builtin_amdgcn_s_setprio(1);
#pragma unroll
    for (int ks = 0; ks < 2; ++ks) {
      bf16x8 wf[4], xf[4];
#pragma unroll
      for (int i = 0; i < 4; ++i) {
        wf[i] = ld8(Bc + (wc * 64 + i * 16 + r16) * 72 + ks * 32 + quad * 8);
        xf[i] = ld8(Ac + (wr * 64 + i * 16 + r16) * 72 + ks * 32 + quad * 8);
      }
#pragma unroll
      for (int nt = 0; nt < 4; ++nt)
#pragma unroll
        for (int mt = 0; mt < 4; ++mt) acc[nt][mt] = mfma16(wf[nt], xf[mt], acc[nt][mt]);
    }
    __builtin_amdgcn_s_setprio(0);
    __syncthreads();
  }
#undef GLD
#undef GLOAD
#undef SST
#undef STORE
  const int colbase = tn * 128 + wc * 64;
  if (MODE == 0) {
    const bool ropeseg = (colbase < 384) || (colbase >= 1792 && colbase < 2304);
#pragma unroll
    for (int mt = 0; mt < 4; ++mt) {
      const int T = tm * 128 + wr * 64 + mt * 16 + r16;
      const bool lat = T >= NCTX;
      if (ropeseg && lat) {
        const int s = (T - NCTX) & 2047;
        const float* rp = p.rope + (size_t)(s * 32 + quad * 4) * 2;
        float4 c0 = *reinterpret_cast<const float4*>(rp);
        float4 c1 = *reinterpret_cast<const float4*>(rp + 4);
        float4 d0 = *reinterpret_cast<const float4*>(rp + 32);
        float4 d1 = *reinterpret_cast<const float4*>(rp + 36);
        float cs[4] = {c0.x, c0.z, c1.x, c1.z}, sn[4] = {c0.y, c0.w, c1.y, c1.w};
        float cs2[4] = {d0.x, d0.z, d1.x, d1.z}, sn2[4] = {d0.y, d0.w, d1.y, d1.w};
#pragma unroll
        for (int j = 0; j < 4; ++j) {
          float x1 = acc[0][mt][j], x2 = acc[1][mt][j];
          acc[0][mt][j] = x1 * cs[j] - x2 * sn[j];
          acc[1][mt][j] = x2 * cs[j] + x1 * sn[j];
          float y1 = acc[2][mt][j], y2 = acc[3][mt][j];
          acc[2][mt][j] = y1 * cs2[j] - y2 * sn2[j];
          acc[3][mt][j] = y2 * cs2[j] + y1 * sn2[j];
        }
      }
#pragma unroll
      for (int nt = 0; nt < 4; ++nt) {
        const int col = colbase + nt * 16 + quad * 4;
        uint2 o;
        o.x = pack2(acc[nt][mt][0], acc[nt][mt][1]);
        o.y = pack2(acc[nt][mt][2], acc[nt][mt][3]);
        *reinterpret_cast<uint2*>(p.proj + (size_t)T * 4096 + col) = o;
        if (!lat) {
          const int b = T >> 8, s = T & 255;
          float4 f = {acc[nt][mt][0], acc[nt][mt][1], acc[nt][mt][2], acc[nt][mt][3]};
          const size_t rowi = (size_t)((b * 4 + l) * 256 + s);
          if (col >= 256 && col < 384) *reinterpret_cast<float4*>(p.out + OUT_WK + rowi * 128 + (col - 256)) = f;
          else if (col >= 384 && col < 512) *reinterpret_cast<float4*>(p.out + OUT_WV + rowi * 128 + (col - 384)) = f;
          else if (col >= 1024 && col < 1280) *reinterpret_cast<float4*>(p.out + OUT_NK + rowi * 256 + (col - 1024)) = f;
          else if (col >= 1280 && col < 1536) *reinterpret_cast<float4*>(p.out + OUT_NV + rowi * 256 + (col - 1280)) = f;
        }
      }
    }
  } else {
#pragma unroll
    for (int mt = 0; mt < 4; ++mt) {
      const int T = tm * 128 + wr * 64 + mt * 16 + r16;
#pragma unroll
      for (int nt = 0; nt < 4; ++nt) {
        const int col = colbase + nt * 16 + quad * 4;
        uint2 o;
        o.x = pack2(acc[nt][mt][0], acc[nt][mt][1]);
        o.y = pack2(acc[nt][mt][2], acc[nt][mt][3]);
        *reinterpret_cast<uint2*>(p.ybuf + (size_t)T * 1024 + col) = o;
      }
    }
  }
}

__device__ void gemm_out(const Params& p, int tile, unsigned char* smem) {
  u16* As = (u16*)smem;
  u16* Bs = As + 160 * 72;
  const int tid = otid(), w = tid >> 6, lane = tid & 63, r16 = lane & 15, quad = lane >> 4;
  const int wr = w >> 1, wc = w & 1;
  const int tm = tile & 127, tn = tile >> 7;
  const u16* Agp = p.hbuf + (size_t)(tm * 160) * HS;
  const u16* Bgp = p.wt_out + (size_t)(tn * 128) * WS;
  f32x4 acc[4][5];
#pragma unroll
  for (int a = 0; a < 4; ++a)
#pragma unroll
    for (int b = 0; b < 5; ++b) acc[a][b] = (f32x4){0.f, 0.f, 0.f, 0.f};
  const int lrow = tid >> 3, lkc = (tid & 7) * 8;
  const unsigned voff_Agp = lrow * HS + lkc, voff_Bgp = lrow * WS + lkc;
  u16* Asp = As + lrow * 72 + lkc;
  u16* Bsp = Bs + lrow * 72 + lkc;
  uint4 ra0, ra1, ra2, ra3, ra4, rb0, rb1, rb2, rb3;
#define GLD(p_, r_, S_) *reinterpret_cast<const uint4*>((p_) + ((size_t)(r_) * 32 * S_ + kofs) + voff_##p_)
#define GLOADO(KO) { const int kofs = (KO); \
  ra0 = GLD(Agp, 0, HS); ra1 = GLD(Agp, 1, HS); ra2 = GLD(Agp, 2, HS); ra3 = GLD(Agp, 3, HS); ra4 = GLD(Agp, 4, HS); \
  rb0 = GLD(Bgp, 0, WS); rb1 = GLD(Bgp, 1, WS); rb2 = GLD(Bgp, 2, WS); rb3 = GLD(Bgp, 3, WS); }
#define SST(p_, r_, v_) *reinterpret_cast<uint4*>((p_) + (r_) * 32 * 72) = v_
  GLOADO(0)
#pragma unroll 1
  for (int kt = 0; kt < 16; ++kt) {
    __syncthreads();
    SST(Asp, 0, ra0); SST(Asp, 1, ra1); SST(Asp, 2, ra2); SST(Asp, 3, ra3); SST(Asp, 4, ra4);
    SST(Bsp, 0, rb0); SST(Bsp, 1, rb1); SST(Bsp, 2, rb2); SST(Bsp, 3, rb3);
    if (kt + 1 < 16) GLOADO((kt + 1) * 64)
    __syncthreads();
    {
      bf16x8 wf0[4], xf0[5], wf1[4], xf1[5];
#pragma unroll
      for (int i = 0; i < 4; ++i) wf0[i] = ld8(Bs + (wc * 64 + i * 16 + r16) * 72 + quad * 8);
#pragma unroll
      for (int i = 0; i < 5; ++i) xf0[i] = ld8(As + (wr * 80 + i * 16 + r16) * 72 + quad * 8);
#pragma unroll
      for (int i = 0; i < 4; ++i) wf1[i] = ld8(Bs + (wc * 64 + i * 16 + r16) * 72 + 32 + quad * 8);
#pragma unroll
      for (int i = 0; i < 5; ++i) xf1[i] = ld8(As + (wr * 80 + i * 16 + r16) * 72 + 32 + quad * 8);
      __builtin_amdgcn_sched_barrier(0);
      __builtin_amdgcn_s_setprio(1);
#pragma unroll
      for (int mt = 0; mt < 5; ++mt)
#pragma unroll
        for (int nt = 0; nt < 4; ++nt) acc[nt][mt] = mfma16(wf0[nt], xf0[mt], acc[nt][mt]);
#pragma unroll
      for (int mt = 0; mt < 5; ++mt)
#pragma unroll
        for (int nt = 0; nt < 4; ++nt) acc[nt][mt] = mfma16(wf1[nt], xf1[mt], acc[nt][mt]);
      __builtin_amdgcn_s_setprio(0);
    }
  }
#undef GLD
#undef GLOADO
#undef SST
  const int colbase = tn * 128 + wc * 64;
#pragma unroll
  for (int mt = 0; mt < 5; ++mt) {
    const int T = tm * 160 + wr * 80 + mt * 16 + r16;
#pragma unroll
    for (int nt = 0; nt < 4; ++nt) {
      const int col = colbase + nt * 16 + quad * 4;
      uint2 o;
      o.x = pack2(acc[nt][mt][0], acc[nt][mt][1]);
      o.y = pack2(acc[nt][mt][2], acc[nt][mt][3]);
      *reinterpret_cast<uint2*>(p.ybuf + (size_t)T * 1024 + col) = o;
    }
  }
}

__device__ void gemm_big(const Params& p, int l, int tile, unsigned char* smem) {
  u16* As = (u16*)smem;
  u16* Bs = As + 256 * 72;
  const int tid = otid(), w = tid >> 6, lane = tid & 63, r16 = lane & 15, quad = lane >> 4;
  const int wr = w >> 1, wc = w & 1;
  int tm, tn;
  {
    const int r = tile >> 9, x = tile & 7, sl = (tile & 511) >> 3;
    const int R = r * 8 + x;
    tm = (R % 10) * 8 + (sl & 7);
    tn = (R / 10) * 8 + (sl >> 3);
  }
  const u16* Ag = p.hbuf + (size_t)(tm * 256) * HS;
  const u16* Bg = p.wt_in + (size_t)(tn * 128) * WS;
  f32x4 acc[4][8];
#pragma unroll
  for (int a = 0; a < 4; ++a)
#pragma unroll
    for (int b = 0; b < 8; ++b) acc[a][b] = (f32x4){0.f, 0.f, 0.f, 0.f};
  const int lrow = tid >> 3, lkc = (tid & 7) * 8;
  const u16* Agp = Ag + (size_t)lrow * HS + lkc;
  const u16* Bgp = Bg + (size_t)lrow * WS + lkc;
  u16* Asp = As + lrow * 72 + lkc;
  u16* Bsp = Bs + lrow * 72 + lkc;
  uint4 ra0, ra1, ra2, ra3, ra4, ra5, ra6, ra7, rb0, rb1, rb2, rb3;
#define GLD(p_, r_, S_) *reinterpret_cast<const uint4*>((p_) + (size_t)(r_) * 32 * S_ + kofs)
#define GLOADB(KO) { const int kofs = (KO); \
  ra0 = GLD(Agp, 0, HS); ra1 = GLD(Agp, 1, HS); ra2 = GLD(Agp, 2, HS); ra3 = GLD(Agp, 3, HS); ra4 = GLD(Agp, 4, HS); ra5 = GLD(Agp, 5, HS); ra6 = GLD(Agp, 6, HS); ra7 = GLD(Agp, 7, HS); \
  rb0 = GLD(Bgp, 0, WS); rb1 = GLD(Bgp, 1, WS); rb2 = GLD(Bgp, 2, WS); rb3 = GLD(Bgp, 3, WS); }
#define SST(p_, r_, v_) *reinterpret_cast<uint4*>((p_) + (r_) * 32 * 72) = v_
  GLOADB(0)
#pragma unroll 1
  for (int kt = 0; kt < 16; ++kt) {
    __syncthreads();
    SST(Asp, 0, ra0); SST(Asp, 1, ra1); SST(Asp, 2, ra2); SST(Asp, 3, ra3); SST(Asp, 4, ra4); SST(Asp, 5, ra5); SST(Asp, 6, ra6); SST(Asp, 7, ra7);
    SST(Bsp, 0, rb0); SST(Bsp, 1, rb1); SST(Bsp, 2, rb2); SST(Bsp, 3, rb3);
    if (kt + 1 < 16) GLOADB((kt + 1) * 64)
    __syncthreads();
    {
      const u16* Bb = Bs + (wc * 64 + r16) * 72 + quad * 8;
      const u16* Ab = As + (wr * 128 + r16) * 72 + quad * 8;
      bf16x8 wf0[4], wf1[4], xr[3];
#pragma unroll
      for (int i = 0; i < 4; ++i) wf0[i] = ld8(Bb + i * 16 * 72);
#pragma unroll
      for (int i = 0; i < 2; ++i) xr[i] = ld8(Ab + i * 16 * 72);
#pragma unroll
      for (int i = 0; i < 4; ++i) wf1[i] = ld8(Bb + i * 16 * 72 + 32);
      __builtin_amdgcn_sched_barrier(0);
      __builtin_amdgcn_s_setprio(1);
#pragma unroll
      for (int st = 0; st < 16; ++st) {
        const int nx = st + 2;
        if (nx < 16) xr[nx % 3] = ld8(Ab + (nx & 7) * 16 * 72 + (nx >> 3) * 32);
        __builtin_amdgcn_sched_barrier(0);
        const int mt = st & 7;
        if (st < 8) {
#pragma unroll
          for (int nt = 0; nt < 4; ++nt) acc[nt][mt] = mfma16(wf0[nt], xr[st % 3], acc[nt][mt]);
        } else {
#pragma unroll
          for (int nt = 0; nt < 4; ++nt) acc[nt][mt] = mfma16(wf1[nt], xr[st % 3], acc[nt][mt]);
        }
        __builtin_amdgcn_sched_barrier(0);
      }
      __builtin_amdgcn_s_setprio(0);
    }
  }
#undef GLD
#undef GLOADB
#undef SST
  const int colbase = tn * 128 + wc * 64;
  const bool ropeseg = (colbase < 384) || (colbase >= 1792 && colbase < 2304);
  __syncthreads();
  u16* stg = (u16*)smem + w * (64 * 72);
#pragma unroll
  for (int half = 0; half < 2; ++half) {
#pragma unroll
    for (int mtl = 0; mtl < 4; ++mtl) {
      const int mt = half * 4 + mtl;
      const int T = tm * 256 + wr * 128 + mt * 16 + r16;
      const bool lat = T >= NCTX;
      if (ropeseg && lat) {
        const int s = (T - NCTX) & 2047;
        const float* rp = p.rope + (size_t)(s * 32 + quad * 4) * 2;
        float4 c0 = *reinterpret_cast<const float4*>(rp);
        float4 c1 = *reinterpret_cast<const float4*>(rp + 4);
        float4 d0 = *reinterpret_cast<const float4*>(rp + 32);
        float4 d1 = *reinterpret_cast<const float4*>(rp + 36);
        float cs[4] = {c0.x, c0.z, c1.x, c1.z}, sn[4] = {c0.y, c0.w, c1.y, c1.w};
        float cs2[4] = {d0.x, d0.z, d1.x, d1.z}, sn2[4] = {d0.y, d0.w, d1.y, d1.w};
#pragma unroll
        for (int j = 0; j < 4; ++j) {
          float x1 = acc[0][mt][j], x2 = acc[1][mt][j];
          acc[0][mt][j] = x1 * cs[j] - x2 * sn[j];
          acc[1][mt][j] = x2 * cs[j] + x1 * sn[j];
          float y1 = acc[2][mt][j], y2 = acc[3][mt][j];
          acc[2][mt][j] = y1 * cs2[j] - y2 * sn2[j];
          acc[3][mt][j] = y2 * cs2[j] + y1 * sn2[j];
        }
      }
#pragma unroll
      for (int nt = 0; nt < 4; ++nt) {
        uint2 o;
        o.x = pack2(acc[nt][mt][0], acc[nt][mt][1]);
        o.y = pack2(acc[nt][mt][2], acc[nt][mt][3]);
        *reinterpret_cast<uint2*>(stg + (mtl * 16 + r16) * 72 + nt * 16 + quad * 4) = o;
        if (!lat) {
          const int col = colbase + nt * 16 + quad * 4;
          const int b = T >> 8, s = T & 255;
          float4 f = {acc[nt][mt][0], acc[nt][mt][1], acc[nt][mt][2], acc[nt][mt][3]};
          const size_t rowi = (size_t)((b * 4 + l) * 256 + s);
          if (col >= 256 && col < 384) *reinterpret_cast<float4*>(p.out + OUT_WK + rowi * 128 + (col - 256)) = f;
          else if (col >= 384 && col < 512) *reinterpret_cast<float4*>(p.out + OUT_WV + rowi * 128 + (col - 384)) = f;
          else if (col >= 1024 && col < 1280) *reinterpret_cast<float4*>(p.out + OUT_NK + rowi * 256 + (col - 1024)) = f;
          else if (col >= 1280 && col < 1536) *reinterpret_cast<float4*>(p.out + OUT_NV + rowi * 256 + (col - 1280)) = f;
        }
      }
    }
    wave_lds_sync();
#pragma unroll
    for (int i = 0; i < 8; ++i) {
      const int row = i * 8 + (lane >> 3), ch = lane & 7;
      uint4 v = *reinterpret_cast<const uint4*>(stg + row * 72 + ch * 8);
      const int T = tm * 256 + wr * 128 + half * 64 + row;
      *reinterpret_cast<uint4*>(p.proj + (size_t)T * 4096 + colbase + ch * 8) = v;
    }
    wave_lds_sync();
  }
}

__device__ __forceinline__ void ld_rows_bf16(u16* dst, const u16* src, size_t stride) {
  const int tid = otid(), row = tid >> 2, part = (tid & 3) * 16;
  const u16* s = src + (size_t)row * stride + part;
  uint4 a = *reinterpret_cast<const uint4*>(s);
  uint4 b = *reinterpret_cast<const uint4*>(s + 8);
  *reinterpret_cast<uint4*>(dst + row * 72 + part) = a;
  *reinterpret_cast<uint4*>(dst + row * 72 + part + 8) = b;
}
__device__ __forceinline__ void ld_rows_f32(u16* dst, const float* src, size_t stride) {
  const int tid = otid(), row = tid >> 2, part = (tid & 3) * 16;
  const float* s = src + (size_t)row * stride + part;
  float4 a = *reinterpret_cast<const float4*>(s), b = *reinterpret_cast<const float4*>(s + 4);
  float4 c = *reinterpret_cast<const float4*>(s + 8), d = *reinterpret_cast<const float4*>(s + 12);
  uint4 o0, o1;
  o0.x = pack2(a.x, a.y); o0.y = pack2(a.z, a.w); o0.z = pack2(b.x, b.y); o0.w = pack2(b.z, b.w);
  o1.x = pack2(c.x, c.y); o1.y = pack2(c.z, c.w); o1.z = pack2(d.x, d.y); o1.w = pack2(d.z, d.w);
  *reinterpret_cast<uint4*>(dst + row * 72 + part) = o0;
  *reinterpret_cast<uint4*>(dst + row * 72 + part + 8) = o1;
}
__device__ __forceinline__ void ld_tr_bf16(u16* dst, const u16* src, size_t stride) {
  const int tid = otid(), dc = tid >> 5, kp = tid & 31;
  uint4 a = *reinterpret_cast<const uint4*>(src + (size_t)(2 * kp) * stride + dc * 8);
  uint4 b = *reinterpret_cast<const uint4*>(src + (size_t)(2 * kp + 1) * stride + dc * 8);
  unsigned av[4] = {a.x, a.y, a.z, a.w}, bv[4] = {b.x, b.y, b.z, b.w};
#pragma unroll
  for (int i = 0; i < 4; ++i) {
    unsigned lo = (av[i] & 0xffffu) | (bv[i] << 16);
    unsigned hi = (av[i] >> 16) | (bv[i] & 0xffff0000u);
    *reinterpret_cast<unsigned*>(dst + (dc * 8 + 2 * i) * 72 + 2 * kp) = lo;
    *reinterpret_cast<unsigned*>(dst + (dc * 8 + 2 * i + 1) * 72 + 2 * kp) = hi;
  }
}
__device__ __forceinline__ void ld_tr_f32(u16* dst, const float* src, size_t stride) {
  const int tid = otid(), dc = tid >> 5, kp = tid & 31;
  const float* s0 = src + (size_t)(2 * kp) * stride + dc * 8;
  const float* s1 = src + (size_t)(2 * kp + 1) * stride + dc * 8;
  float4 a0 = *reinterpret_cast<const float4*>(s0), a1 = *reinterpret_cast<const float4*>(s0 + 4);
  float4 b0 = *reinterpret_cast<const float4*>(s1), b1 = *reinterpret_cast<const float4*>(s1 + 4);
  float av[8] = {a0.x, a0.y, a0.z, a0.w, a1.x, a1.y, a1.z, a1.w};
  float bv[8] = {b0.x, b0.y, b0.z, b0.w, b1.x, b1.y, b1.z, b1.w};
#pragma unroll
  for (int i = 0; i < 8; ++i) *reinterpret_cast<unsigned*>(dst + (dc * 8 + i) * 72 + 2 * kp) = pack2(av[i], bv[i]);
}

#define DEFER_THR 10.0f
template <int NSUB, class F>
__device__ __forceinline__ void attn_step(const u16* Ksh, const u16* Vt, int kbeg, const bf16x8 (&aq)[2],
                                          f32x4 (&o)[4], float& m, float& ls, F maskf, int r16, int quad) {
  f32x4 st[NSUB];
#pragma unroll
  for (int t = 0; t < NSUB; ++t) {
    st[t] = (f32x4){0.f, 0.f, 0.f, 0.f};
#pragma unroll
    for (int ks = 0; ks < 2; ++ks) st[t] = mfma16(ld8(Ksh + (kbeg + t * 16 + r16) * 72 + ks * 32 + quad * 8), aq[ks], st[t]);
  }
  float mx = -1e30f;
#pragma unroll
  for (int t = 0; t < NSUB; ++t)
#pragma unroll
    for (int j = 0; j < 4; ++j) {
      st[t][j] = maskf(kbeg + t * 16 + quad * 4 + j, st[t][j] * (0.125f * LOG2E));
      mx = fmaxf(mx, st[t][j]);
    }
  mx = fmaxf(mx, __shfl_xor(mx, 16));
  mx = fmaxf(mx, __shfl_xor(mx, 32));
  float al = 1.f;
  __builtin_amdgcn_sched_barrier(0);
  if (__any(mx - m > DEFER_THR)) {
    const float mn = fmaxf(m, mx);
    al = fexp2(m - mn);
    m = mn;
#pragma unroll
    for (int n = 0; n < 4; ++n)
#pragma unroll
      for (int j = 0; j < 4; ++j) o[n][j] *= al;
  }
  __builtin_amdgcn_sched_barrier(0);
  float rs = 0.f;
#pragma unroll
  for (int t = 0; t < NSUB; ++t)
#pragma unroll
    for (int j = 0; j < 4; ++j) {
      float pv = fexp2(st[t][j] - m);
      st[t][j] = pv;
      rs += pv;
    }
  ls = ls * al + rs;
#pragma unroll
  for (int s2 = 0; s2 < NSUB / 2; ++s2) {
    union { unsigned u[4]; bf16x8 v; } bp;
    bp.u[0] = pack2(st[2 * s2][0], st[2 * s2][1]);
    bp.u[1] = pack2(st[2 * s2][2], st[2 * s2][3]);
    bp.u[2] = pack2(st[2 * s2 + 1][0], st[2 * s2 + 1][1]);
    bp.u[3] = pack2(st[2 * s2 + 1][2], st[2 * s2 + 1][3]);
#pragma unroll
    for (int n = 0; n < 4; ++n) {
      const u16* vp = Vt + (n * 16 + r16) * 72 + kbeg + s2 * 32 + quad * 4;
      union { uint2 h[2]; bf16x8 v; } av;
      av.h[0] = *reinterpret_cast<const uint2*>(vp);
      av.h[1] = *reinterpret_cast<const uint2*>(vp + 16);
      o[n] = mfma16(av.v, bp.v, o[n]);
    }
  }
}

struct KVb { uint4 k0, k1, v0, v1; };
struct KVf { float4 k0, k1, k2, k3, v0, v1, v2, v3; };
__device__ __forceinline__ void kv_issue_b(uint4& rk0, uint4& rk1, uint4& rv0, uint4& rv1, const u16* ks, const u16* vs, size_t stride, int tid) {
  const int row = tid >> 2, part = (tid & 3) * 16;
  const u16* s = ks + (size_t)row * stride + part;
  rk0 = *reinterpret_cast<const uint4*>(s);
  rk1 = *reinterpret_cast<const uint4*>(s + 8);
  const int dc = tid >> 5, kp = tid & 31;
  rv0 = *reinterpret_cast<const uint4*>(vs + (size_t)(2 * kp) * stride + dc * 8);
  rv1 = *reinterpret_cast<const uint4*>(vs + (size_t)(2 * kp + 1) * stride + dc * 8);
}
__device__ __forceinline__ void kv_commit_b(const uint4& rk0, const uint4& rk1, const uint4& rv0, const uint4& rv1, u16* Ksh, u16* Vt, int tid) {
  const int row = tid >> 2, part = (tid & 3) * 16;
  *reinterpret_cast<uint4*>(Ksh + row * 72 + part) = rk0;
  *reinterpret_cast<uint4*>(Ksh + row * 72 + part + 8) = rk1;
  const int dc = tid >> 5, kp = tid & 31;
  unsigned av[4] = {rv0.x, rv0.y, rv0.z, rv0.w}, bv[4] = {rv1.x, rv1.y, rv1.z, rv1.w};
#pragma unroll
  for (int i = 0; i < 4; ++i) {
    unsigned lo = (av[i] & 0xffffu) | (bv[i] << 16);
    unsigned hi = (av[i] >> 16) | (bv[i] & 0xffff0000u);
    *reinterpret_cast<unsigned*>(Vt + (dc * 8 + 2 * i) * 72 + 2 * kp) = lo;
    *reinterpret_cast<unsigned*>(Vt + (dc * 8 + 2 * i + 1) * 72 + 2 * kp) = hi;
  }
}
__device__ __forceinline__ void kv_issue_f(float4& fk0, float4& fk1, float4& fk2, float4& fk3, float4& fv0, float4& fv1, float4& fv2, float4& fv3, const float* ks, const float* vs, size_t stride, int tid) {
  const int row = tid >> 2, part = (tid & 3) * 16;
  const float* s = ks + (size_t)row * stride + part;
  fk0 = *reinterpret_cast<const float4*>(s);
  fk1 = *reinterpret_cast<const float4*>(s + 4);
  fk2 = *reinterpret_cast<const float4*>(s + 8);
  fk3 = *reinterpret_cast<const float4*>(s + 12);
  const int dc = tid >> 5, kp = tid & 31;
  const float* s0 = vs + (size_t)(2 * kp) * stride + dc * 8;
  const float* s1 = vs + (size_t)(2 * kp + 1) * stride + dc * 8;
  fv0 = *reinterpret_cast<const float4*>(s0);
  fv1 = *reinterpret_cast<const float4*>(s0 + 4);
  fv2 = *reinterpret_cast<const float4*>(s1);
  fv3 = *reinterpret_cast<const float4*>(s1 + 4);
}
__device__ __forceinline__ void kv_commit_f(const float4& fk0, const float4& fk1, const float4& fk2, const float4& fk3, const float4& fv0, const float4& fv1, const float4& fv2, const float4& fv3, u16* Ksh, u16* Vt, int tid) {
  const int row = tid >> 2, part = (tid & 3) * 16;
  uint4 o0, o1;
  o0.x = pack2(fk0.x, fk0.y); o0.y = pack2(fk0.z, fk0.w); o0.z = pack2(fk1.x, fk1.y); o0.w = pack2(fk1.z, fk1.w);
  o1.x = pack2(fk2.x, fk2.y); o1.y = pack2(fk2.z, fk2.w); o1.z = pack2(fk3.x, fk3.y); o1.w = pack2(fk3.z, fk3.w);
  *reinterpret_cast<uint4*>(Ksh + row * 72 + part) = o0;
  *reinterpret_cast<uint4*>(Ksh + row * 72 + part + 8) = o1;
  const int dc = tid >> 5, kp = tid & 31;
  float av[8] = {fv0.x, fv0.y, fv0.z, fv0.w, fv1.x, fv1.y, fv1.z, fv1.w};
  float bv[8] = {fv2.x, fv2.y, fv2.z, fv2.w, fv3.x, fv3.y, fv3.z, fv3.w};
#pragma unroll
  for (int i = 0; i < 8; ++i) *reinterpret_cast<unsigned*>(Vt + (dc * 8 + i) * 72 + 2 * kp) = pack2(av[i], bv[i]);
}

template <int KIND>
__device__ void attn_item(const Params& p, int l, int it, unsigned char* smem) {
  u16* Ksh = (u16*)smem;
  u16* Vt = Ksh + 64 * 72;
  float* rpbs = (float*)(Vt + 64 * 72);
  const int tid = otid(), w = tid >> 6, lane = tid & 63, r16 = lane & 15, quad = lane >> 4;
  int b, h, qt, Tq0;
  if (KIND < 2) { b = it >> 3; h = (it >> 1) & 3; qt = it & 1; Tq0 = b * 256 + qt * 128; }
  else { b = it >> 6; h = (it >> 4) & 3; qt = it & 15; Tq0 = NCTX + b * 2048 + qt * 128; }
  const bool isA = (KIND == 0 || KIND == 2);
  const int qcol = isA ? 0 : 768, gcol = isA ? 512 : 1536, mixcol = isA ? 0 : 256;
  const int kv = h >> 1;
  int qoff[2];
  if (KIND == 3) { qoff[0] = (w >> 1) * 64 + (w & 1) * 32; qoff[1] = qoff[0] + 16; }
  else { qoff[0] = w * 32; qoff[1] = w * 32 + 16; }
  bf16x8 aq[2][2];
  uint2 gpre[2][4];
#pragma unroll
  for (int g = 0; g < 2; ++g) {
    const size_t rowo = (size_t)(Tq0 + qoff[g] + r16) * 4096;
    const u16* qp = p.proj + rowo + qcol + h * 64 + quad * 8;
    aq[g][0] = ld8(qp);
    aq[g][1] = ld8(qp + 32);
    const u16* gp = p.proj + rowo + gcol + h * 64 + quad * 4;
#pragma unroll
    for (int n = 0; n < 4; ++n) gpre[g][n] = *reinterpret_cast<const uint2*>(gp + n * 16);
  }
  f32x4 o[2][4];
  float m[2] = {-1e30f, -1e30f}, ls[2] = {0.f, 0.f};
#pragma unroll
  for (int g = 0; g < 2; ++g)
#pragma unroll
    for (int n = 0; n < 4; ++n) o[g][n] = (f32x4){0.f, 0.f, 0.f, 0.f};
  auto nomask = [](int, float s) { return s; };

  int nloc, loc0, ktlo = 0, R0 = 0;
  const int kcol = isA ? 256 + kv * 64 : 1024 + h * 64;
  const int vcol = isA ? 384 + kv * 64 : 1280 + h * 64;
  if (KIND < 2) { nloc = 4; loc0 = b * 256; }
  else if (KIND == 2) {
    ktlo = 2 * qt - 2; if (ktlo < 0) ktlo = 0;
    int kthi = 2 * qt + 3; if (kthi > 31) kthi = 31;
    nloc = kthi - ktlo + 1;
    loc0 = NCTX + b * 2048 + ktlo * 64;
  } else {
    const int r0 = 2 * qt;
    R0 = r0 - 4; R0 = R0 < 0 ? 0 : (R0 > 24 ? 24 : R0);
    int R1 = r0 + 1 - 4; R1 = R1 < 0 ? 0 : (R1 > 24 ? 24 : R1);
    nloc = R1 + 8 - R0;
    loc0 = NCTX + b * 2048 + R0 * 64;
  }
  const int ntot = nloc + (KIND >= 2 ? 4 : 0);
  const u16* ck = nullptr; const u16* cv = nullptr; int cstride = 0;
  if (KIND == 2) { const size_t ro = (size_t)(b * 256) * 128 + kv * 64; ck = p.cbak + ro; cv = p.cbav + ro; cstride = 128; }
  if (KIND == 3) { const size_t ro = (size_t)(b * 256) * 256 + h * 64; ck = p.cbbk + ro; cv = p.cbbv + ro; cstride = 256; }
  int kbeg[2] = {0, 0};
  int myrow = 0, myR0 = 0;
  if (KIND == 3) {
    myrow = 2 * qt + (w >> 1);
    myR0 = myrow - 4; myR0 = myR0 < 0 ? 0 : (myR0 > 24 ? 24 : myR0);
#pragma unroll
    for (int g = 0; g < 2; ++g) {
      const int cb = (w & 1) * 2 + g;
      int kb = 16 * cb - 8; kb = kb < 0 ? 0 : (kb > 32 ? 32 : kb);
      kbeg[g] = kb;
    }
    __syncthreads();
    for (int i = tid; i < 15 * 31; i += 256) rpbs[i] = p.rpb[(size_t)((l * 4 + h) * 15) * 31 + i] * LOG2E;
  }
  uint4 ak0, ak1, av0, av1, bk0, bk1, bv0, bv1;
  auto issue = [&](int vt, uint4& k0, uint4& k1, uint4& v0, uint4& v1) {
    if (vt < nloc) {
      const u16* base = p.proj + (size_t)(loc0 + vt * 64) * 4096;
      kv_issue_b(k0, k1, v0, v1, base + kcol, base + vcol, 4096, tid);
    } else {
      const size_t ro = (size_t)((vt - nloc) * 64) * cstride;
      kv_issue_b(k0, k1, v0, v1, ck + ro, cv + ro, (size_t)cstride, tid);
    }
  };
  auto do_step = [&](int vt) {
#pragma unroll
    for (int g = 0; g < 2; ++g) {
      if (vt >= nloc || KIND < 2) {
        attn_step<4>(Ksh, Vt, 0, aq[g], o[g], m[g], ls[g], nomask, r16, quad);
      } else if (KIND == 2) {
        const int kpos0 = (ktlo + vt) * 64 - qt * 128;
        const int qa = qoff[g];
        const bool skip = (qa - (kpos0 + 63) > 128) || (qa + 15 - kpos0 < -128);
        if (!skip) {
          const int qrel = qa + r16 - kpos0;
          auto mk = [qrel](int key, float s) {
            int d = qrel - key;
            return (d <= 128 && d >= -128) ? s : -1e30f;
          };
          attn_step<4>(Ksh, Vt, 0, aq[g], o[g], m[g], ls[g], mk, r16, quad);
        }
      } else {
        const int kr = R0 + vt;
        if (kr >= myR0 && kr < myR0 + 8) {
          const int qc = ((w & 1) * 2 + g) * 16 + r16;
          int qws = qc - 8; qws = qws < 0 ? 0 : (qws > 48 ? 48 : qws);
          const float* rbp = rpbs + (kr - myrow + 7) * 31 + 15 - qc;
          auto mk = [qws, rbp](int key, float s) {
            bool ok = (key >= qws) && (key < qws + 16);
            return ok ? (s + rbp[ok ? key : qws]) : -1e30f;
          };
          attn_step<2>(Ksh, Vt, kbeg[g], aq[g], o[g], m[g], ls[g], mk, r16, quad);
        }
      }
    }
  };
  issue(0, ak0, ak1, av0, av1);
  if (ntot > 1) issue(1, bk0, bk1, bv0, bv1);
#pragma unroll 1
  for (int vt = 0; vt < ntot; vt += 2) {
    __syncthreads();
    kv_commit_b(ak0, ak1, av0, av1, Ksh, Vt, tid);
    __syncthreads();
    if (vt + 2 < ntot) issue(vt + 2, ak0, ak1, av0, av1);
    do_step(vt);
    if (vt + 1 < ntot) {
      __syncthreads();
      kv_commit_b(bk0, bk1, bv0, bv1, Ksh, Vt, tid);
      __syncthreads();
      if (vt + 3 < ntot) issue(vt + 3, bk0, bk1, bv0, bv1);
      do_step(vt + 1);
    }
  }
#pragma unroll
  for (int g = 0; g < 2; ++g) {
    float tot = ls[g] + __shfl_xor(ls[g], 16);
    tot += __shfl_xor(tot, 32);
    float sc = 1.f;
    if (isA) {
      const float sk = p.sink[l * 4 + h] * LOG2E;
      const float mn = fmaxf(m[g], sk);
      const float al = fexp2(m[g] - mn);
      tot = tot * al + fexp2(sk - mn);
      sc = al;
    }
    const float inv = sc / tot;
    const int T = Tq0 + qoff[g] + r16;
#pragma unroll
    for (int n = 0; n < 4; ++n) {
      const int dv = n * 16 + quad * 4;
      const uint2 gg = gpre[g][n];
      uint2 ov;
      ov.x = pack2(o[g][n][0] * inv * silu_f(bflo(gg.x)), o[g][n][1] * inv * silu_f(bfhi(gg.x)));
      ov.y = pack2(o[g][n][2] * inv * silu_f(bflo(gg.y)), o[g][n][3] * inv * silu_f(bfhi(gg.y)));
      *reinterpret_cast<uint2*>(p.hbuf + (size_t)T * HS + mixcol + h * 64 + dv) = ov;
    }
  }
  __syncthreads();
}

__device__ void csum_item(const Params& p, int l, int it, unsigned char* smem) {
  u16* Ktf = (u16*)smem;
  u16* Ktb = Ktf + 64 * 72;
  u16* Vt = Ktb + 64 * 72;
  const int tid = otid(), w = tid >> 6, lane = tid & 63, r16 = lane & 15, quad = lane >> 4;
  const int c = it >> 2, h = it & 3, T0 = c * 64;
  const float lgf = ret_lg2(p, l, 0, h), lgb = ret_lg2(p, l, 1, h);
  __syncthreads();
  {
    const int dc = tid >> 5, kp = tid & 31, j0 = 2 * kp, j1 = j0 + 1;
    const u16* kb = p.proj + (size_t)(T0 + j0) * 4096 + 2048 + h * 64 + dc * 8;
    uint4 a = *reinterpret_cast<const uint4*>(kb);
    uint4 b = *reinterpret_cast<const uint4*>(kb + 4096);
    unsigned av[4] = {a.x, a.y, a.z, a.w}, bv[4] = {b.x, b.y, b.z, b.w};
    const float wf0 = 0.125f * fexp2(lgf * (float)(63 - j0)), wf1 = 0.125f * fexp2(lgf * (float)(63 - j1));
    const float wb0 = 0.125f * fexp2(lgb * (float)j0), wb1 = 0.125f * fexp2(lgb * (float)j1);
#pragma unroll
    for (int i = 0; i < 4; ++i) {
      float k0l = bflo(av[i]), k0h = bfhi(av[i]), k1l = bflo(bv[i]), k1h = bfhi(bv[i]);
      *reinterpret_cast<unsigned*>(Ktf + (dc * 8 + 2 * i) * 72 + j0) = pack2(k0l * wf0, k1l * wf1);
      *reinterpret_cast<unsigned*>(Ktf + (dc * 8 + 2 * i + 1) * 72 + j0) = pack2(k0h * wf0, k1h * wf1);
      *reinterpret_cast<unsigned*>(Ktb + (dc * 8 + 2 * i) * 72 + j0) = pack2(k0l * wb0, k1l * wb1);
      *reinterpret_cast<unsigned*>(Ktb + (dc * 8 + 2 * i + 1) * 72 + j0) = pack2(k0h * wb0, k1h * wb1);
    }
  }
  ld_tr_bf16(Vt, p.proj + (size_t)T0 * 4096 + 2304 + h * 64, 4096);
  __syncthreads();
#pragma unroll
  for (int dir = 0; dir < 2; ++dir) {
    const u16* Kt = dir ? Ktb : Ktf;
    f32x4 acc[4];
#pragma unroll
    for (int mt = 0; mt < 4; ++mt) acc[mt] = (f32x4){0.f, 0.f, 0.f, 0.f};
#pragma unroll
    for (int ks = 0; ks < 2; ++ks) {
      bf16x8 bv = ld8(Vt + (w * 16 + r16) * 72 + ks * 32 + quad * 8);
#pragma unroll
      for (int mt = 0; mt < 4; ++mt) acc[mt] = mfma16(ld8(Kt + (mt * 16 + r16) * 72 + ks * 32 + quad * 8), bv, acc[mt]);
    }
    u16* U = p.uc + (size_t)((c * 4 + h) * 2 + dir) * 4096 + (w * 16 + r16) * 64;
#pragma unroll
    for (int mt = 0; mt < 4; ++mt) {
      uint2 o;
      o.x = pack2(acc[mt][0], acc[mt][1]);
      o.y = pack2(acc[mt][2], acc[mt][3]);
      *reinterpret_cast<uint2*>(U + mt * 16 + quad * 4) = o;
    }
  }
  __syncthreads();
}

__device__ __forceinline__ void hgrn_gates(const uint4 a, const uint4 b, int dir, const float* lbs, float* Bc, float* kkf, u16* kkb, float* segtot) {
  const int tid = otid();
  {
    const int j = tid >> 2, part = (tid & 3) * 16;
    unsigned zz[8] = {a.x, a.y, a.z, a.w, b.x, b.y, b.z, b.w};
    float lfv[16], kfv[16];
#pragma unroll
    for (int i = 0; i < 16; ++i) {
      float z = (i & 1) ? bfhi(zz[i >> 1]) : bflo(zz[i >> 1]);
      float lb = fmaxf(lbs[dir * 64 + part + i], 1e-30f);
      float sneg = __builtin_amdgcn_rcpf(1.f + __expf(z));
      float spos = __builtin_amdgcn_rcpf(1.f + __expf(-z));
      kfv[i] = (1.f - lb) * sneg;
      float f = lb + (1.f - lb) * spos;
      lfv[i] = __log2f(fmaxf(f, 1e-30f));
    }
#pragma unroll
    for (int i = 0; i < 4; ++i) {
      *reinterpret_cast<float4*>(Bc + j * 68 + part + 4 * i) = make_float4(lfv[4 * i], lfv[4 * i + 1], lfv[4 * i + 2], lfv[4 * i + 3]);
      if (kkf) *reinterpret_cast<float4*>(kkf + j * 68 + part + 4 * i) = make_float4(kfv[4 * i], kfv[4 * i + 1], kfv[4 * i + 2], kfv[4 * i + 3]);
    }
    if (kkb) {
      uint4 o0, o1;
      o0.x = pack2(kfv[0], kfv[1]); o0.y = pack2(kfv[2], kfv[3]); o0.z = pack2(kfv[4], kfv[5]); o0.w = pack2(kfv[6], kfv[7]);
      o1.x = pack2(kfv[8], kfv[9]); o1.y = pack2(kfv[10], kfv[11]); o1.z = pack2(kfv[12], kfv[13]); o1.w = pack2(kfv[14], kfv[15]);
      *reinterpret_cast<uint4*>(kkb + j * 72 + part) = o0;
      *reinterpret_cast<uint4*>(kkb + j * 72 + part + 8) = o1;
    }
  }
  __syncthreads();
  const int ch = tid & 63, seg = tid >> 6;
  float v[16];
#pragma unroll
  for (int jj = 0; jj < 16; ++jj) v[jj] = Bc[(seg * 16 + jj) * 68 + ch];
  float tot;
  if (dir == 0) {
#pragma unroll
    for (int jj = 1; jj < 16; ++jj) v[jj] += v[jj - 1];
    tot = v[15];
  } else {
#pragma unroll
    for (int jj = 14; jj >= 0; --jj) v[jj] += v[jj + 1];
    tot = v[0];
  }
  segtot[seg * 64 + ch] = tot;
  __syncthreads();
  float off = 0.f;
#pragma unroll
  for (int s2 = 0; s2 < 4; ++s2) {
    const float t2 = segtot[s2 * 64 + ch];
    const bool use = dir ? (s2 > seg) : (s2 < seg);
    off += use ? t2 : 0.f;
  }
#pragma unroll
  for (int jj = 0; jj < 16; ++jj) Bc[(seg * 16 + jj) * 68 + ch] = v[jj] + off;
  __syncthreads();
}

__device__ void dsum_item(const Params& p, int l, int it, unsigned char* smem) {
  float* Bc = (float*)smem;
  float* kk = Bc + 64 * 68;
  u16* Kt = (u16*)(kk + 64 * 68);
  u16* Vt = Kt + 64 * 72;
  float* lbs = (float*)(Vt + 64 * 72);
  const int tid = otid(), w = tid >> 6, lane = tid & 63, r16 = lane & 15, quad = lane >> 4;
  const int c = it >> 2, h = it & 3, T0 = c * 64;
  __syncthreads();
  uint4 zf0, zf1, zb0, zb1;
  {
    const u16* zp = p.proj + (size_t)(T0 + (tid >> 2)) * 4096 + 3072 + h * 64 + (tid & 3) * 16;
    zf0 = *reinterpret_cast<const uint4*>(zp); zf1 = *reinterpret_cast<const uint4*>(zp + 8);
    zb0 = *reinterpret_cast<const uint4*>(zp + 256); zb1 = *reinterpret_cast<const uint4*>(zp + 264);
  }
  if (tid < 128) lbs[tid] = hgrn_lb(p, l, tid >> 6, h * 64 + (tid & 63));
  ld_tr_bf16(Vt, p.proj + (size_t)T0 * 4096 + 3584 + h * 64, 4096);
  __syncthreads();
#pragma unroll
  for (int dir = 0; dir < 2; ++dir) {
    hgrn_gates(dir ? zb0 : zf0, dir ? zb1 : zf1, dir, lbs, Bc, kk, nullptr, lbs + 128);
    const int lastj = dir ? 0 : 63;
    {
      const int j = tid >> 2, part = (tid & 3) * 16;
#pragma unroll
      for (int i4 = 0; i4 < 4; ++i4) {
        const int ch = part + 4 * i4;
        float4 kv4 = *reinterpret_cast<const float4*>(kk + j * 68 + ch);
        float4 bl = *reinterpret_cast<const float4*>(Bc + lastj * 68 + ch);
        float4 bj = *reinterpret_cast<const float4*>(Bc + j * 68 + ch);
        Kt[(ch + 0) * 72 + j] = f2bf(kv4.x * fexp2(bl.x - bj.x));
        Kt[(ch + 1) * 72 + j] = f2bf(kv4.y * fexp2(bl.y - bj.y));
        Kt[(ch + 2) * 72 + j] = f2bf(kv4.z * fexp2(bl.z - bj.z));
        Kt[(ch + 3) * 72 + j] = f2bf(kv4.w * fexp2(bl.w - bj.w));
      }
    }
    if (tid < 64) p.dg[(size_t)((c * 4 + h) * 2 + dir) * 64 + tid] = fexp2(Bc[lastj * 68 + tid]);
    __syncthreads();
    f32x4 acc[4];
#pragma unroll
    for (int mt = 0; mt < 4; ++mt) acc[mt] = (f32x4){0.f, 0.f, 0.f, 0.f};
#pragma unroll
    for (int ks = 0; ks < 2; ++ks) {
      bf16x8 bv = ld8(Vt + (w * 16 + r16) * 72 + ks * 32 + quad * 8);
#pragma unroll
      for (int mt = 0; mt < 4; ++mt) acc[mt] = mfma16(ld8(Kt + (mt * 16 + r16) * 72 + ks * 32 + quad * 8), bv, acc[mt]);
    }
    u16* U = p.ud + (size_t)((c * 4 + h) * 2 + dir) * 4096 + (w * 16 + r16) * 64;
#pragma unroll
    for (int mt = 0; mt < 4; ++mt) {
      uint2 o;
      o.x = pack2(acc[mt][0], acc[mt][1]);
      o.y = pack2(acc[mt][2], acc[mt][3]);
      *reinterpret_cast<uint2*>(U + mt * 16 + quad * 4) = o;
    }
    __syncthreads();
  }
}

template <int ISD, int NB>
__device__ __forceinline__ void scan_batch(u16* U, const float* dgp, int c0, int cstep, int h, int dir, int e, int dk, float dec,
                                           float& S0, float& S1, float& S2, float& S3) {
  unsigned u[NB], w2[NB];
  float2 d[NB];
#pragma unroll
  for (int i = 0; i < NB; ++i) {
    const int c = c0 + i * cstep;
    const size_t blk = (size_t)((c * 4 + h) * 2 + dir);
    u[i] = *reinterpret_cast<const unsigned*>(U + blk * 4096 + e);
    w2[i] = *reinterpret_cast<const unsigned*>(U + blk * 4096 + e + 2048);
    if (ISD) d[i] = *reinterpret_cast<const float2*>(dgp + blk * 64 + dk);
  }
#pragma unroll
  for (int i = 0; i < NB; ++i) {
    const int c = c0 + i * cstep;
    const size_t blk = (size_t)((c * 4 + h) * 2 + dir);
    *reinterpret_cast<unsigned*>(U + blk * 4096 + e) = pack2(S0, S1);
    *reinterpret_cast<unsigned*>(U + blk * 4096 + e + 2048) = pack2(S2, S3);
    const float d0 = ISD ? d[i].x : dec, d1 = ISD ? d[i].y : dec;
    S0 = S0 * d0 + bflo(u[i]);
    S1 = S1 * d1 + bfhi(u[i]);
    S2 = S2 * d0 + bflo(w2[i]);
    S3 = S3 * d1 + bfhi(w2[i]);
  }
}
template <int ISD>
__device__ void scan_item(const Params& p, int l, int it) {
  const int tid = otid();
  const int part = it & 3, dir = (it >> 2) & 1, h = (it >> 3) & 3, sidx = it >> 5;
  const int e = (part * 256 + tid) * 2, dv = e >> 6, dk = e & 63;
  const bool ctx = sidx < 16;
  const int nch = ctx ? 4 : 32;
  const int cb = ctx ? sidx * 4 : 64 + (sidx - 16) * 32;
  u16* U = ISD ? p.ud : p.uc;
  float dec = 0.f;
  if (!ISD) dec = fexp2(64.f * ret_lg2(p, l, dir, h));
  float S0 = 0.f, S1 = 0.f, S2 = 0.f, S3 = 0.f;
  if (!ctx) {
    const float* st = (ISD ? p.st_hgrn : p.st_ret) + (size_t)((((sidx - 16) * 4 + l) * 2 + dir) * 4 + h) * 4096;
    S0 = st[dk * 64 + dv];
    S1 = st[(dk + 1) * 64 + dv];
    S2 = st[dk * 64 + dv + 32];
    S3 = st[(dk + 1) * 64 + dv + 32];
  }
  const int cstart = dir ? (cb + nch - 1) : cb, cstep = dir ? -1 : 1;
  if (ctx) {
    scan_batch<ISD, 4>(U, p.dg, cstart, cstep, h, dir, e, dk, dec, S0, S1, S2, S3);
    float* os = p.out + (ISD ? OUT_SH : OUT_SR) + (size_t)(((sidx * 4 + l) * 2 + dir) * 4 + h) * 4096;
    os[dk * 64 + dv] = S0;
    os[(dk + 1) * 64 + dv] = S1;
    os[dk * 64 + dv + 32] = S2;
    os[(dk + 1) * 64 + dv + 32] = S3;
  } else {
    scan_batch<ISD, 16>(U, p.dg, cstart, cstep, h, dir, e, dk, dec, S0, S1, S2, S3);
    scan_batch<ISD, 16>(U, p.dg, cstart + 16 * cstep, cstep, h, dir, e, dk, dec, S0, S1, S2, S3);
  }
}

__device__ __forceinline__ void load_gate_rows(const Params& p, int Trow0, int gcol, int lane, uint4& g0, uint4& g1) {
  const int row = lane >> 2, c0 = (lane & 3) * 16;
  const u16* gp = p.proj + (size_t)(Trow0 + row) * 4096 + gcol + c0;
  g0 = *reinterpret_cast<const uint4*>(gp);
  g1 = *reinterpret_cast<const uint4*>(gp + 8);
}
__device__ __forceinline__ void store_rows_gated(const Params& p, float* stg  , const float (&val)[4][4],
                                                 int Trow0, const uint4 g0, const uint4 g1, int mcol, int lane) {
  const int r16 = lane & 15, quad = lane >> 4;
#pragma unroll
  for (int n = 0; n < 4; ++n)
#pragma unroll
    for (int j = 0; j < 4; ++j) stg[(quad * 4 + j) * 68 + n * 16 + r16] = val[n][j];
  wave_lds_sync();
  const int row = lane >> 2, c0 = (lane & 3) * 16;
  const int T = Trow0 + row;
  unsigned gw[8] = {g0.x, g0.y, g0.z, g0.w, g1.x, g1.y, g1.z, g1.w};
  unsigned ow[8];
#pragma unroll
  for (int i = 0; i < 4; ++i) {
    float4 v = *reinterpret_cast<const float4*>(stg + row * 68 + c0 + 4 * i);
    ow[2 * i] = pack2(v.x * silu_f(bflo(gw[2 * i])), v.y * silu_f(bfhi(gw[2 * i])));
    ow[2 * i + 1] = pack2(v.z * silu_f(bflo(gw[2 * i + 1])), v.w * silu_f(bfhi(gw[2 * i + 1])));
  }
  u16* op = p.hbuf + (size_t)T * HS + mcol + c0;
  *reinterpret_cast<uint4*>(op) = make_uint4(ow[0], ow[1], ow[2], ow[3]);
  *reinterpret_cast<uint4*>(op + 8) = make_uint4(ow[4], ow[5], ow[6], ow[7]);
}

__device__ void cout_item(const Params& p, int l, int it, unsigned char* smem) {
  u16* Qs = (u16*)smem;
  u16* Ks = Qs + 64 * 72;
  u16* Vt = Ks + 64 * 72;
  u16* SfT = Vt + 64 * 72;
  u16* SbT = SfT + 64 * 72;
  u16* Ps = SbT + 64 * 72;
  const int tid = otid(), w = tid >> 6, lane = tid & 63, r16 = lane & 15, quad = lane >> 4;
  const int c = it >> 2, h = it & 3, T0 = c * 64;
  const float lgf = ret_lg2(p, l, 0, h), lgb = ret_lg2(p, l, 1, h);
  uint4 gt0, gt1;
  load_gate_rows(p, T0 + w * 16, 2560 + h * 64, lane, gt0, gt1);
  __syncthreads();
  const u16* base = p.proj + (size_t)T0 * 4096;
  ld_rows_bf16(Qs, base + 1792 + h * 64, 4096);
  ld_rows_bf16(Ks, base + 2048 + h * 64, 4096);
  ld_tr_bf16(Vt, base + 2304 + h * 64, 4096);
  ld_rows_bf16(SfT, p.uc + (size_t)((c * 4 + h) * 2 + 0) * 4096, 64);
  ld_rows_bf16(SbT, p.uc + (size_t)((c * 4 + h) * 2 + 1) * 4096, 64);
  __syncthreads();
  const int i0 = w * 16;
  bf16x8 aq[2];
  aq[0] = ld8(Qs + (i0 + r16) * 72 + quad * 8);
  aq[1] = ld8(Qs + (i0 + r16) * 72 + 32 + quad * 8);
  f32x4 s[4];
#pragma unroll
  for (int nt = 0; nt < 4; ++nt) {
    s[nt] = (f32x4){0.f, 0.f, 0.f, 0.f};
#pragma unroll
    for (int ks = 0; ks < 2; ++ks) s[nt] = mfma16(aq[ks], ld8(Ks + (nt * 16 + r16) * 72 + ks * 32 + quad * 8), s[nt]);
  }
#pragma unroll
  for (int nt = 0; nt < 4; ++nt)
#pragma unroll
    for (int j = 0; j < 4; ++j) {
      const int i = i0 + quad * 4 + j, jj = nt * 16 + r16, d = i - jj;
      float wgt = (d > 0) ? fexp2(lgf * (float)d) : ((d < 0) ? fexp2(lgb * (float)(-d)) : 2.f);
      Ps[i * 72 + jj] = f2bf(s[nt][j] * 0.125f * wgt);
    }
  wave_lds_sync();
  f32x4 o[4], xf[4], xb[4];
#pragma unroll
  for (int n = 0; n < 4; ++n) { o[n] = (f32x4){0.f, 0.f, 0.f, 0.f}; xf[n] = o[n]; xb[n] = o[n]; }
#pragma unroll
  for (int ks = 0; ks < 2; ++ks) {
    bf16x8 ap = ld8(Ps + (i0 + r16) * 72 + ks * 32 + quad * 8);
#pragma unroll
    for (int n = 0; n < 4; ++n) {
      o[n] = mfma16(ap, ld8(Vt + (n * 16 + r16) * 72 + ks * 32 + quad * 8), o[n]);
      xf[n] = mfma16(aq[ks], ld8(SfT + (n * 16 + r16) * 72 + ks * 32 + quad * 8), xf[n]);
      xb[n] = mfma16(aq[ks], ld8(SbT + (n * 16 + r16) * 72 + ks * 32 + quad * 8), xb[n]);
    }
  }
  float val[4][4];
#pragma unroll
  for (int j = 0; j < 4; ++j) {
    const int i = i0 + quad * 4 + j;
    const float qf = fexp2(lgf * (float)(i + 1)), qb = fexp2(lgb * (float)(64 - i));
    float t[4], sum = 0.f;
#pragma unroll
    for (int n = 0; n < 4; ++n) { t[n] = o[n][j] + qf * xf[n][j] + qb * xb[n][j]; sum += t[n]; }
    const float mu = gsum16(sum) * (1.f / 64.f);
    float vs = 0.f;
#pragma unroll
    for (int n = 0; n < 4; ++n) { t[n] -= mu; vs += t[n] * t[n]; }
    const float rstd = rsqrtf(gsum16(vs) * (1.f / 64.f) + 1e-6f);
#pragma unroll
    for (int n = 0; n < 4; ++n) val[n][j] = t[n] * rstd;
  }
  __syncthreads();
  store_rows_gated(p, (float*)smem + w * (16 * 68), val, T0 + i0, gt0, gt1, 512 + h * 64, lane);
  __syncthreads();
}

__device__ void dout_item(const Params& p, int l, int it, unsigned char* smem) {
  u16* qs = (u16*)smem;
  u16* Vt = qs + 64 * 72;
  u16* kkb = Vt + 64 * 72;
  u16* Kt = kkb + 64 * 72;
  u16* ST = Kt + 64 * 72;
  u16* Ps = ST + 64 * 72;
  float* Bc = (float*)(Ps + 64 * 72);
  float* Rref = Bc + 64 * 68;
  float* lbs = Rref + 256;
  const int tid = otid(), w = tid >> 6, lane = tid & 63, r16 = lane & 15, quad = lane >> 4;
  const int c = it >> 2, h = it & 3, T0 = c * 64;
  uint4 gt0, gt1;
  load_gate_rows(p, T0 + w * 16, 3840 + h * 64, lane, gt0, gt1);
  uint4 zf0, zf1, zb0, zb1, sf0, sf1, sb0, sb1;
  {
    const int row = tid >> 2, part = (tid & 3) * 16;
    const u16* zp = p.proj + (size_t)(T0 + row) * 4096 + 3072 + h * 64 + part;
    zf0 = *reinterpret_cast<const uint4*>(zp); zf1 = *reinterpret_cast<const uint4*>(zp + 8);
    zb0 = *reinterpret_cast<const uint4*>(zp + 256); zb1 = *reinterpret_cast<const uint4*>(zp + 264);
    const u16* sp = p.ud + (size_t)((c * 4 + h) * 2) * 4096 + row * 64 + part;
    sf0 = *reinterpret_cast<const uint4*>(sp); sf1 = *reinterpret_cast<const uint4*>(sp + 8);
    sb0 = *reinterpret_cast<const uint4*>(sp + 4096); sb1 = *reinterpret_cast<const uint4*>(sp + 4096 + 8);
  }
  __syncthreads();
  if (tid < 128) lbs[tid] = hgrn_lb(p, l, tid >> 6, h * 64 + (tid & 63));
  {
    const int row = tid >> 2, part = (tid & 3) * 16;
    const u16* s = p.proj + (size_t)(T0 + row) * 4096 + 2816 + h * 64 + part;
    uint4 a = *reinterpret_cast<const uint4*>(s), b = *reinterpret_cast<const uint4*>(s + 8);
    unsigned zz[8] = {a.x, a.y, a.z, a.w, b.x, b.y, b.z, b.w};
#pragma unroll
    for (int i = 0; i < 8; ++i) zz[i] = pack2(silu_f(bflo(zz[i])), silu_f(bfhi(zz[i])));
    uint4 o0 = {zz[0], zz[1], zz[2], zz[3]}, o1 = {zz[4], zz[5], zz[6], zz[7]};
    *reinterpret_cast<uint4*>(qs + row * 72 + part) = o0;
    *reinterpret_cast<uint4*>(qs + row * 72 + part + 8) = o1;
  }
  ld_tr_bf16(Vt, p.proj + (size_t)T0 * 4096 + 3584 + h * 64, 4096);
  f32x4 o[4];
#pragma unroll
  for (int n = 0; n < 4; ++n) o[n] = (f32x4){0.f, 0.f, 0.f, 0.f};
  const int I = w;
#pragma unroll
  for (int dir = 0; dir < 2; ++dir) {
    __syncthreads();
    {
      const int row = tid >> 2, part = (tid & 3) * 16;
      *reinterpret_cast<uint4*>(ST + row * 72 + part) = dir ? sb0 : sf0;
      *reinterpret_cast<uint4*>(ST + row * 72 + part + 8) = dir ? sb1 : sf1;
    }
    hgrn_gates(dir ? zb0 : zf0, dir ? zb1 : zf1, dir, lbs, Bc, nullptr, kkb, Rref);
    Rref[tid] = Bc[((tid >> 6) * 16 + (dir ? 0 : 15)) * 68 + (tid & 63)];
    __syncthreads();
    {
      const int j = tid >> 2, part = (tid & 3) * 16;
      unsigned ov[8];
      uint4 kk0 = *reinterpret_cast<const uint4*>(kkb + j * 72 + part), kk1 = *reinterpret_cast<const uint4*>(kkb + j * 72 + part + 8);
      unsigned kw[8] = {kk0.x, kk0.y, kk0.z, kk0.w, kk1.x, kk1.y, kk1.z, kk1.w};
#pragma unroll
      for (int i4 = 0; i4 < 4; ++i4) {
        float4 rr = *reinterpret_cast<const float4*>(Rref + (j >> 4) * 64 + part + 4 * i4);
        float4 bb = *reinterpret_cast<const float4*>(Bc + j * 68 + part + 4 * i4);
        ov[2 * i4] = pack2(bflo(kw[2 * i4]) * fexp2(rr.x - bb.x), bfhi(kw[2 * i4]) * fexp2(rr.y - bb.y));
        ov[2 * i4 + 1] = pack2(bflo(kw[2 * i4 + 1]) * fexp2(rr.z - bb.z), bfhi(kw[2 * i4 + 1]) * fexp2(rr.w - bb.w));
      }
      uint4 o0 = {ov[0], ov[1], ov[2], ov[3]}, o1 = {ov[4], ov[5], ov[6], ov[7]};
      *reinterpret_cast<uint4*>(Kt + j * 72 + part) = o0;
      *reinterpret_cast<uint4*>(Kt + j * 72 + part + 8) = o1;
    }
    __syncthreads();
    f32x4 sacc[4];
#pragma unroll
    for (int J = 0; J < 4; ++J) sacc[J] = (f32x4){0.f, 0.f, 0.f, 0.f};
    const int irow = 16 * I + r16;
#pragma unroll
    for (int J = 0; J < 4; ++J) {
      const bool act = dir ? (J > I) : (J < I);
      if (act) {
#pragma unroll
        for (int ks = 0; ks < 2; ++ks) {
          const int ch0 = ks * 32 + quad * 8;
          uint4 qv = *reinterpret_cast<const uint4*>(qs + irow * 72 + ch0);
          unsigned qq[4] = {qv.x, qv.y, qv.z, qv.w};
          float4 b0 = *reinterpret_cast<const float4*>(Bc + irow * 68 + ch0), b1 = *reinterpret_cast<const float4*>(Bc + irow * 68 + ch0 + 4);
          float4 r0 = *reinterpret_cast<const float4*>(Rref + J * 64 + ch0), r1 = *reinterpret_cast<const float4*>(Rref + J * 64 + ch0 + 4);
          union { unsigned u[4]; bf16x8 v; } a;
          a.u[0] = pack2(bflo(qq[0]) * fexp2(b0.x - r0.x), bfhi(qq[0]) * fexp2(b0.y - r0.y));
          a.u[1] = pack2(bflo(qq[1]) * fexp2(b0.z - r0.z), bfhi(qq[1]) * fexp2(b0.w - r0.w));
          a.u[2] = pack2(bflo(qq[2]) * fexp2(b1.x - r1.x), bfhi(qq[2]) * fexp2(b1.y - r1.y));
          a.u[3] = pack2(bflo(qq[3]) * fexp2(b1.z - r1.z), bfhi(qq[3]) * fexp2(b1.w - r1.w));
          sacc[J] = mfma16(a.v, ld8(Kt + (16 * J + r16) * 72 + ch0), sacc[J]);
        }
      }
    }
#pragma unroll
    for (int J = 0; J < 4; ++J)
#pragma unroll
      for (int j = 0; j < 4; ++j) Ps[(16 * I + quad * 4 + j) * 72 + 16 * J + r16] = f2bf(sacc[J][j]);
    {
      const int rbase = 16 * I;
#pragma unroll 3
      for (int itq = 0; itq < 9; ++itq) {
        const int qp = itq * 64 + lane;
        const bool valid = qp < 544;
        const int pp = valid ? (qp >> 2) : 0, cq = qp & 3;
        int a2 = (int)((sqrtf(8.f * (float)pp + 1.f) - 1.f) * 0.5f);
        if ((a2 + 1) * (a2 + 2) / 2 <= pp) ++a2;
        if (a2 * (a2 + 1) / 2 > pp) --a2;
        const int b2 = pp - a2 * (a2 + 1) / 2;
        const int i = rbase + (dir ? b2 : a2), key = rbase + (dir ? a2 : b2);
        float sum = 0.f;
#pragma unroll
        for (int c8 = 0; c8 < 2; ++c8) {
          const int ch0 = cq * 16 + c8 * 8;
          uint4 kq = *reinterpret_cast<const uint4*>(kkb + key * 72 + ch0);
          unsigned kq4[4] = {kq.x, kq.y, kq.z, kq.w};
          float4 bk0 = *reinterpret_cast<const float4*>(Bc + key * 68 + ch0);
          float4 bk1 = *reinterpret_cast<const float4*>(Bc + key * 68 + ch0 + 4);
          float bk[8] = {bk0.x, bk0.y, bk0.z, bk0.w, bk1.x, bk1.y, bk1.z, bk1.w};
          uint4 qv = *reinterpret_cast<const uint4*>(qs + i * 72 + ch0);
          unsigned qq[4] = {qv.x, qv.y, qv.z, qv.w};
          float4 bi0 = *reinterpret_cast<const float4*>(Bc + i * 68 + ch0);
          float4 bi1 = *reinterpret_cast<const float4*>(Bc + i * 68 + ch0 + 4);
          float bi[8] = {bi0.x, bi0.y, bi0.z, bi0.w, bi1.x, bi1.y, bi1.z, bi1.w};
#pragma unroll
          for (int e2 = 0; e2 < 4; ++e2) {
            float w0 = fexp2(fminf(bi[2 * e2] - bk[2 * e2], 0.f));
            float w1 = fexp2(fminf(bi[2 * e2 + 1] - bk[2 * e2 + 1], 0.f));
            sum += bflo(qq[e2]) * bflo(kq4[e2]) * w0 + bfhi(qq[e2]) * bfhi(kq4[e2]) * w1;
          }
        }
        sum += DPPF(sum, 0xB1);
        sum += DPPF(sum, 0x4E);
        if (valid && cq == 0) Ps[i * 72 + key] = f2bf(sum);
      }
    }
    wave_lds_sync();
#pragma unroll
    for (int ks = 0; ks < 2; ++ks) {
      const int ch0 = ks * 32 + quad * 8;
      bf16x8 ap = ld8(Ps + irow * 72 + ch0);
      uint4 qv = *reinterpret_cast<const uint4*>(qs + irow * 72 + ch0);
      unsigned qq[4] = {qv.x, qv.y, qv.z, qv.w};
      float4 b0 = *reinterpret_cast<const float4*>(Bc + irow * 68 + ch0), b1 = *reinterpret_cast<const float4*>(Bc + irow * 68 + ch0 + 4);
      union { unsigned u[4]; bf16x8 v; } a;
      a.u[0] = pack2(bflo(qq[0]) * fexp2(b0.x), bfhi(qq[0]) * fexp2(b0.y));
      a.u[1] = pack2(bflo(qq[1]) * fexp2(b0.z), bfhi(qq[1]) * fexp2(b0.w));
      a.u[2] = pack2(bflo(qq[2]) * fexp2(b1.x), bfhi(qq[2]) * fexp2(b1.y));
      a.u[3] = pack2(bflo(qq[3]) * fexp2(b1.z), bfhi(qq[3]) * fexp2(b1.w));
#pragma unroll
      for (int n = 0; n < 4; ++n) {
        o[n] = mfma16(ap, ld8(Vt + (n * 16 + r16) * 72 + ch0), o[n]);
        o[n] = mfma16(a.v, ld8(ST + (n * 16 + r16) * 72 + ch0), o[n]);
      }
    }
  }
  float val[4][4];
#pragma unroll
  for (int j = 0; j < 4; ++j) {
    float ss = 0.f;
#pragma unroll
    for (int n = 0; n < 4; ++n) ss += o[n][j] * o[n][j];
    const float rstd = rsqrtf(gsum16(ss) * (1.f / 64.f) + 1e-6f);
#pragma unroll
    for (int n = 0; n < 4; ++n) val[n][j] = o[n][j] * rstd;
  }
  __syncthreads();
  store_rows_gated(p, (float*)smem + w * (16 * 68), val, T0 + 16 * I, gt0, gt1, 768 + h * 64, lane);
  __syncthreads();
}

#define XB_TMO      128
#define XB_XCNT(j)  (256  + 64 * (j))
#define XB_XSUB(j)  (1280 + 64 * (j))
#define XB_XGEN(j)  (2304 + 64 * (j))
#define XB_TOP      3328
#define XB_TOPGEN   3392
#define XCD_BAR_WORDS 3456
#define XB_SPIN_CAP (1u << 18)
#define LAS __attribute__((address_space(3)))
__device__ __forceinline__ unsigned xb_ld(unsigned* p)              { return __hip_atomic_load(p, __ATOMIC_RELAXED, __HIP_MEMORY_SCOPE_AGENT); }
__device__ __forceinline__ unsigned xb_add(unsigned* p, unsigned v) { return __hip_atomic_fetch_add(p, v, __ATOMIC_RELAXED, __HIP_MEMORY_SCOPE_AGENT); }
__device__ __forceinline__ unsigned xb_xcc_id() { return (unsigned)__builtin_amdgcn_s_getreg((3 << 11) | 20) & 0xFu; }
#define XB_SPIN(cond, bar) do { unsigned _sp = 0; while (cond) { __builtin_amdgcn_s_sleep(1); \
    if ((++_sp & 255u) == 0u) { if (xb_ld(&(bar)[XB_TMO])) break; if (_sp > XB_SPIN_CAP) { atomicAdd(&(bar)[XB_TMO], 1u); break; } } } } while (0)
struct XcdBarrier { unsigned* bar; unsigned x; volatile LAS unsigned* st; };
__device__ __forceinline__ XcdBarrier xcd_barrier_post(unsigned* bar, volatile LAS unsigned* st) {
    XcdBarrier b; b.bar = bar; b.x = xb_xcc_id(); b.st = st;
    if (threadIdx.x == 0) (void)xb_add(&bar[XB_XCNT(b.x)], 1u);
    return b;
}
__device__ __forceinline__ void xcd_barrier_complete(unsigned* bar, unsigned x, unsigned& nloc, unsigned& nx) {
    const unsigned G = gridDim.x * gridDim.y * gridDim.z;
    unsigned sum, cnt, mine, sp = 0u;
    for (;;) {
        sum = 0u; cnt = 0u; mine = 0u;
#pragma unroll
        for (unsigned j = 0; j < 16; ++j) { const unsigned c = xb_ld(&bar[XB_XCNT(j)]); sum += c; cnt += (c > 0u) ? 1u : 0u; mine = (j == x) ? c : mine; }
        if (sum == G) break;
        __builtin_amdgcn_s_sleep(1);
        if ((++sp & 255u) == 0u) { if (xb_ld(&bar[XB_TMO])) break; if (sp > XB_SPIN_CAP) { atomicAdd(&bar[XB_TMO], 1u); break; } }
    }
    nloc = mine > 0u ? mine : 1u; nx = cnt > 0u ? cnt : 1u;
}
__device__ __forceinline__ void xcd_barrier(const XcdBarrier& b) {
    asm volatile("s_waitcnt vmcnt(0)" ::: "memory");
    __syncthreads();
    if (threadIdx.x == 0) {
        unsigned* bar = b.bar;
        __builtin_amdgcn_s_waitcnt(0);
        unsigned nloc = b.st[0], nx = b.st[1];
        if (nloc == 0u) { xcd_barrier_complete(bar, b.x, nloc, nx); b.st[0] = nloc; b.st[1] = nx; }
        const unsigned old = xb_add(&bar[XB_XSUB(b.x)], 1u);
        const unsigned gen = old / nloc;
        if (old + 1u == (gen + 1u) * nloc) {
            __builtin_amdgcn_fence(__ATOMIC_RELEASE, "agent");
            asm volatile("s_waitcnt vmcnt(0)" ::: "memory");
            const unsigned og = xb_add(&bar[XB_TOP], 1u);
            const unsigned tg = og / nx;
            if (og + 1u == (tg + 1u) * nx) xb_add(&bar[XB_TOPGEN], 1u);
            else XB_SPIN(xb_ld(&bar[XB_TOPGEN]) == tg, bar);
            __builtin_amdgcn_fence(__ATOMIC_ACQUIRE, "agent");
            xb_add(&bar[XB_XGEN(b.x)], 1u);
            asm volatile("s_waitcnt vmcnt(0)" ::: "memory");
        } else {
            XB_SPIN(xb_ld(&bar[XB_XGEN(b.x)]) == gen, bar);
            __builtin_amdgcn_fence(__ATOMIC_ACQUIRE, "agent");
            asm volatile("s_waitcnt vmcnt(0)" ::: "memory");
        }
    }
    __syncthreads();
}

__global__ void __launch_bounds__(256, 2) mega(Params p) {
  extern __shared__ __attribute__((aligned(16))) unsigned char smem[];
  const int nb = gridDim.x, bid = blockIdx.x;
  volatile LAS unsigned* xst = (volatile LAS unsigned*)(smem + LDS_BYTES - 16);
  if (threadIdx.x == 0) { xst[0] = 0u; xst[1] = 0u; xst[2] = 0u; xst[3] = 0u; }
  __syncthreads();
  XcdBarrier xb = xcd_barrier_post(p.bar, xst);
#pragma unroll 1
  for (int it = bid; it < 192 + 256 + 1024 + 256; it += nb) {
    if (it < 192) adaln_item(p, it, smem);
    else if (it < 448) rope_item(p, it - 192);
    else if (it < 1472) conv_tile(p.w_in, 4096, p.wt_in, it - 448, smem);
    else conv_tile(p.w_out, 1024, p.wt_out, it - 1472, smem);
  }
  xcd_barrier(xb);
#pragma unroll 1
  for (int l = 0; l < 4; ++l) {
#pragma unroll 1
    for (int rep = 0; rep < REP_P1 - 1; ++rep) prep_phase<1>(p, l, bid, nb);
    prep_phase<0>(p, l, bid, nb);
    {
    }
    xcd_barrier(xb);
#pragma unroll 1
    for (int rep = 0; rep < REP_P2; ++rep)
#pragma unroll 1
    for (int it = bid; it < 2560; it += nb) gemm_big(p, l, it, smem);
    xcd_barrier(xb);
    for (int e = 0; e < EXTRA_SYNC; ++e) xcd_barrier(xb);
    {
      const int n = 128 + 128 + 1280 + 1280;
#pragma unroll 1
      for (int rep = 0; rep < REP_P3A; ++rep)
#pragma unroll 1
      for (int it = bid; it < n; it += nb) {
        if (it < 128) attn_item<0>(p, l, it, smem);
        else if (it < 256) attn_item<1>(p, l, it - 128, smem);
        else if (it < 1536) dsum_item(p, l, it - 256, smem);
        else csum_item(p, l, it - 1536, smem);
      }
      if (bid >= (nb >> 1)) {
        const int hb = nb - (nb >> 1);
#pragma unroll 1
        for (int ci = bid - (nb >> 1); ci < 768; ci += hb) cache_conv_item(p, l, ci);
      }
    }
    xcd_barrier(xb);
    {
      const int n = 512 + 512 + 768 + 768;
#pragma unroll 1
      for (int rep = 0; rep < REP_P3B - 1; ++rep)
#pragma unroll 1
      for (int it = bid; it < 1024; it += nb) {
        if (it < 512) attn_item<2>(p, l, it, smem);
        else attn_item<3>(p, l, it - 512, smem);
      }
#pragma unroll 1
      for (int it = bid; it < n; it += nb) {
        if (it < 512) attn_item<2>(p, l, it, smem);
        else if (it < 1024) attn_item<3>(p, l, it - 512, smem);
        else if (it < 1792) scan_item<0>(p, l, it - 1024);
        else scan_item<1>(p, l, it - 1792);
      }
    }
    xcd_barrier(xb);
#pragma unroll 1
    for (int rep = 0; rep < REP_P3C; ++rep)
#pragma unroll 1
    for (int it = bid; it < 2560; it += nb) {
      if (it < 1280) dout_item(p, l, it, smem);
      else cout_item(p, l, it - 1280, smem);
    }
    if (bid >= (nb >> 1)) {
      const int hb = nb - (nb >> 1);
      if (l < 3) {
#pragma unroll 1
        for (int ci = bid - (nb >> 1); ci < 1024; ci += hb) conv_tile(p.w_in + (size_t)(l + 1) * 1024 * 4096, 4096, p.wt_in, ci, smem);
      }
      if (l > 0) {
#pragma unroll 1
        for (int ci = bid - (nb >> 1); ci < 256; ci += hb) conv_tile(p.w_out + (size_t)l * 1024 * 1024, 1024, p.wt_out, ci, smem);
      }
    }
    xcd_barrier(xb);
#pragma unroll 1
    for (int rep = 0; rep < REP_P4; ++rep)
#pragma unroll 1
    for (int it = bid; it < 1024; it += nb) gemm_out(p, it, smem);
    xcd_barrier(xb);
  }
  prep_phase<0>(p, 4, bid, nb);
}

extern "C" void kernel_launch(void* const* d_in, const int* in_sizes, int n_in, void* d_out, int out_size, void* d_ws,
                              size_t ws_size, hipStream_t stream) {
  static int grid_blocks = 0;
  if (!grid_blocks) {
    int dev = 0, cus = 0, per_cu = 0;
    hipGetDevice(&dev);
    hipDeviceGetAttribute(&cus, hipDeviceAttributeMultiprocessorCount, dev);
    hipFuncSetAttribute((const void*)mega, hipFuncAttributeMaxDynamicSharedMemorySize, LDS_BYTES);
    hipOccupancyMaxActiveBlocksPerMultiprocessor(&per_cu, (const void*)mega, 256, LDS_BYTES);
    if (per_cu < 1) per_cu = 1;
    if (per_cu > 2) per_cu = 2;
    grid_blocks = cus * per_cu;
  }
  Params p{};
  const float* const* in = (const float* const*)d_in;
  p.x_prompt = in[0]; p.x_sample = in[1]; p.c = in[2]; p.cwk = in[3]; p.cwv = in[4]; p.cnk = in[5]; p.cnv = in[6];
  p.st_ret = in[7]; p.st_hgrn = in[8]; p.c_ctx = in[9]; p.w_ada = in[10]; p.b_ada = in[11]; p.g_pre = in[12];
  p.g_post = in[13]; p.w_in = in[14]; p.w_out = in[15]; p.sink = in[16]; p.rpb = in[17]; p.ret_logit = in[18];
  p.lb_logit = in[19];
  p.out = (float*)d_out;
  unsigned char* ws = (unsigned char*)d_ws;
  size_t off = 0;
  p.wt_in = (u16*)(ws + off); off += (size_t)4096 * WS * 2;
  p.wt_out = (u16*)(ws + off); off += (size_t)1024 * WS * 2;
  p.hbuf = (u16*)(ws + off); off += (size_t)NTOK * HS * 2;
  p.proj = (u16*)(ws + off); p.ybuf = (u16*)(ws + off); off += (size_t)NTOK * 4096 * 2;
  p.uc = (u16*)(ws + off); off += (size_t)320 * 4 * 2 * 4096 * 2;
  p.ud = (u16*)(ws + off); off += (size_t)320 * 4 * 2 * 4096 * 2;
  p.dg = (float*)(ws + off); off += (size_t)320 * 4 * 2 * 64 * 4;
  p.mod = (float*)(ws + off); off += (size_t)4 * 9 * 3072 * 4;
  p.rope = (float*)(ws + off); off += (size_t)2048 * 32 * 2 * 4;
  p.bar = (unsigned*)(ws + off); off += (size_t)XCD_BAR_WORDS * 4;
  off = (off + 255) & ~(size_t)255;
  p.cbak = (u16*)(ws + off); off += (size_t)8 * 256 * 128 * 2;
  p.cbav = (u16*)(ws + off); off += (size_t)8 * 256 * 128 * 2;
  p.cbbk = (u16*)(ws + off); off += (size_t)8 * 256 * 256 * 2;
  p.cbbv = (u16*)(ws + off); off += (size_t)8 * 256 * 256 * 2;
  if (off > ws_size) { fprintf(stderr, "workspace too small: need %zu have %zu\n", off, ws_size); return; }
  if (hipMemsetAsync(p.bar, 0, (size_t)XCD_BAR_WORDS * 4, stream) != hipSuccess) { fprintf(stderr, "memset failed\n"); return; }
  void* args[] = {&p};
  hipError_t e = hipLaunchCooperativeKernel((const void*)mega, dim3(grid_blocks), dim3(256), args, LDS_BYTES, stream);
  if (e != hipSuccess) fprintf(stderr, "cooperative launch failed: %s (grid %d)\n", hipGetErrorString(e), grid_blocks);
}
```
